# Optimizing an MI355X kernel written in HIP

```python
import math
import jax, jax.numpy as jnp
from jax import lax
import numpy as np

D_MODEL = 1024
BATCH = 8
SEQ = 2048
DEPTH = 2
DEC_BATCH = 128
DEC_SEQ = 1
PAST_LEN = 2048
PAGE_SIZE = 128

N_SB_LAYERS = (DEPTH + 1) // 2
N_RET_LAYERS = DEPTH // 2
SB_HEADS = 8
SB_HEAD_DIM = 64
SB_WIDTH = SB_HEADS * SB_HEAD_DIM
QBLOCK = 128
SB_BIAS_INIT = -6.0
POOL_WINDOWS = (2, 4, 8, 16)
POOL_GROUP = 128
POOL_WIDTH = len(POOL_WINDOWS) * POOL_GROUP
POOL_BUF = max(POOL_WINDOWS) - 1
EVEN_IN = 3 * SB_WIDTH + POOL_WIDTH
EVEN_MIX = SB_WIDTH + POOL_WIDTH
RET_HEADS = 4
RET_QK_DIM = 256
RET_V_DIM = 512
RET_QK_WIDTH = RET_HEADS * RET_QK_DIM
RET_V_WIDTH = RET_HEADS * RET_V_DIM
ODD_IN = 2 * RET_QK_WIDTH + 2 * RET_V_WIDTH
RET_CHUNK = 128
ROPE_BASE = 10000.0
D_FF = 2816
N_SUB = 3
NORM_EPS = 1e-6

kernel_name = 'hybrid_stickbreak_pool_retention_step'


def rmsnorm(x, g):
    xf = x.astype(jnp.float32)
    y = xf * lax.rsqrt(jnp.mean(xf * xf, axis=-1, keepdims=True) + NORM_EPS)
    return (y * g.astype(jnp.float32)).astype(x.dtype)


def adaln_pre(x, m, g):
    return rmsnorm(x, g) * (1 + m[:, 1][:, None]) + m[:, 0][:, None]


def adaln_post(x, y, m, g, res_w):
    return x + res_w * m[:, 2][:, None] * rmsnorm(y, g)


def swiglu(h, w_in, w_out):
    gt, up = jnp.split(h @ w_in, 2, axis=-1)
    return (jax.nn.silu(gt) * up) @ w_out


def rotary(x, pos):
    half = x.shape[-1] // 2
    inv = ROPE_BASE ** (-jnp.arange(half, dtype=jnp.float32) / half)
    ang = pos[:, None] * inv[None, :]
    cos = jnp.cos(ang)[None, :, None, :]
    sin = jnp.sin(ang)[None, :, None, :]
    xf = x.astype(jnp.float32)
    x1, x2 = xf[..., :half], xf[..., half:]
    return jnp.concatenate([x1 * cos - x2 * sin, x1 * sin + x2 * cos], axis=-1).astype(x.dtype)


def stick_breaking(q, k, v, q_pos0, sb_bias):
    T = q.shape[1]
    scale = SB_HEAD_DIM ** -0.5
    bias = sb_bias.astype(jnp.float32)[None, :, None, None]
    outs = []
    for qs in range(0, T, QBLOCK):
        qe = min(qs + QBLOCK, T)
        kend = max(q_pos0 + qe - 1, 1)
        qb, kb, vb = q[:, qs:qe], k[:, :kend], v[:, :kend]
        q_pos = q_pos0 + jnp.arange(qs, qe)
        k_pos = jnp.arange(kend)
        mask = k_pos[None, :] < q_pos[:, None]
        z = jnp.einsum('bqhd,bkhd->bhqk', qb, kb).astype(jnp.float32) * scale + bias
        log_1m = jnp.where(mask, jax.nn.log_sigmoid(-z), 0.0)
        log_w = jax.nn.log_sigmoid(z) + lax.cumsum(log_1m, axis=3, reverse=True) - log_1m
        w = jnp.where(mask, jnp.exp(log_w), 0.0)
        outs.append(jnp.einsum('bhqk,bkhd->bqhd', w.astype(vb.dtype), vb))
    return jnp.concatenate(outs, axis=1)


def multiscale_pool(u_ext, n_new, pool_w, pool_scale):
    B, PT, C = u_ext.shape
    n_prev = PT - n_new
    cs = jnp.concatenate([jnp.zeros((B, 1, C), jnp.float32),
                          jnp.cumsum(u_ext.astype(jnp.float32), axis=1)], axis=1)
    end = n_prev + 1 + jnp.arange(n_new)
    cs_end = cs[:, end]
    means = []
    for gi, w in enumerate(POOL_WINDOWS):
        start = jnp.maximum(end - w, 0)
        cnt = (end - start).astype(jnp.float32)[None, :, None]
        lo, hi = gi * POOL_GROUP, (gi + 1) * POOL_GROUP
        means.append((cs_end[..., lo:hi] - cs[:, start, lo:hi]) / cnt)
    mean = jnp.concatenate(means, axis=-1)
    d = (mean - u_ext[:, n_prev:].astype(jnp.float32)).astype(u_ext.dtype)
    d = d.reshape(B, n_new, len(POOL_WINDOWS), POOL_GROUP)
    y = jnp.einsum('btgc,gcd->btgd', d, pool_w).reshape(B, n_new, POOL_WIDTH)
    return y * pool_scale


def even_mixer(h, w_in, sb_bias, pool_w, pool_scale, w_out, k_past, v_past, pool_buf):
    B, T, _ = h.shape
    q, k, v, u = jnp.split(h @ w_in, [SB_WIDTH, 2 * SB_WIDTH, 3 * SB_WIDTH], axis=-1)
    q = q.reshape(B, T, SB_HEADS, SB_HEAD_DIM)
    k = k.reshape(B, T, SB_HEADS, SB_HEAD_DIM)
    v = v.reshape(B, T, SB_HEADS, SB_HEAD_DIM)
    if k_past is None:
        k_all, v_all, u_ext, pos0 = k, v, u, 0
    else:
        k_all = jnp.concatenate([k_past.astype(k.dtype), k], axis=1)
        v_all = jnp.concatenate([v_past.astype(v.dtype), v], axis=1)
        u_ext = jnp.concatenate([pool_buf.astype(u.dtype), u], axis=1)
        pos0 = k_past.shape[1]
    o_sb = stick_breaking(q, k_all, v_all, pos0, sb_bias).reshape(B, T, SB_WIDTH)
    o_pool = multiscale_pool(u_ext, T, pool_w, pool_scale)
    y = jnp.concatenate([o_sb, o_pool], axis=-1) @ w_out
    return y, k, v, u_ext[:, -POOL_BUF:]


def retention_chunk(S, q, k, v, log_gamma):
    L = q.shape[1]
    i = jnp.arange(L, dtype=jnp.float32)
    diff = i[:, None] - i[None, :]
    decay = jnp.where(diff[None] >= 0,
                      jnp.exp(jnp.maximum(diff, 0.0)[None] * log_gamma[:, None, None]), 0.0)
    scores = jnp.einsum('blhd,bmhd->bhlm', q, k) * decay[None]
    intra = jnp.einsum('bhlm,bmhe->blhe', scores, v)
    cross = jnp.einsum('blhd,bhde->blhe', q, S) * jnp.exp((i[:, None] + 1.0) * log_gamma[None, :])[None, :, :, None]
    k_dec = k * jnp.exp((L - 1.0 - i)[:, None] * log_gamma[None, :])[None, :, :, None]
    S_new = jnp.exp(L * log_gamma)[None, :, None, None] * S + jnp.einsum('blhd,blhe->bhde', k_dec, v)
    return S_new, intra + cross


def retention_mixer(h, w_in, w_out, S0, pos0):
    B, T, _ = h.shape
    q, k, v, g = jnp.split(h @ w_in, [RET_QK_WIDTH, 2 * RET_QK_WIDTH, 2 * RET_QK_WIDTH + RET_V_WIDTH], axis=-1)
    pos = pos0 + jnp.arange(T, dtype=jnp.float32)
    q = rotary(q.reshape(B, T, RET_HEADS, RET_QK_DIM), pos).astype(jnp.float32)
    k = rotary(k.reshape(B, T, RET_HEADS, RET_QK_DIM), pos).astype(jnp.float32) * (RET_QK_DIM ** -0.5)
    v = v.reshape(B, T, RET_HEADS, RET_V_DIM).astype(jnp.float32)
    log_gamma = jnp.log(1.0 - jnp.exp2(-5.0 - jnp.arange(RET_HEADS, dtype=jnp.float32)))
    if S0 is None:
        S0 = jnp.zeros((B, RET_HEADS, RET_QK_DIM, RET_V_DIM), jnp.float32)
    else:
        S0 = S0.astype(jnp.float32)
    if T % RET_CHUNK == 0:
        nc = T // RET_CHUNK
        xs = tuple(jnp.moveaxis(a.reshape(B, nc, RET_CHUNK, a.shape[2], a.shape[3]), 1, 0) for a in (q, k, v))
        S, o = lax.scan(lambda s, inp: retention_chunk(s, inp[0], inp[1], inp[2], log_gamma), S0, xs)
        o = jnp.moveaxis(o, 0, 1).reshape(B, T, RET_HEADS, RET_V_DIM)
    else:
        S, o = retention_chunk(S0, q, k, v, log_gamma)
    mu = jnp.mean(o, axis=-1, keepdims=True)
    var = jnp.mean(jnp.square(o - mu), axis=-1, keepdims=True)
    o = ((o - mu) * lax.rsqrt(var + 1e-5)).reshape(B, T, RET_V_WIDTH).astype(h.dtype)
    return (o * jax.nn.silu(g)) @ w_out, S


def run_trunk(x, c, sb_past, pool_past, ret_past, pos0, params):
    (w_ada, b_ada, norm_pre, norm_post, ffn_w_in, ffn_w_out,
     w_in_even, sb_bias, pool_w, pool_scale, w_out_even, w_in_odd, w_out_odd) = params
    B = x.shape[0]
    cond = jax.nn.silu(c)
    new_k, new_v, new_pool, new_ret = [], [], [], []
    for l in range(DEPTH):
        mod = (cond @ w_ada[l] + b_ada[l]).reshape(B, N_SUB, 3, D_MODEL)
        h = adaln_pre(x, mod[:, 0], norm_pre[l, 0])
        x = adaln_post(x, swiglu(h, ffn_w_in[l, 0], ffn_w_out[l, 0]), mod[:, 0], norm_post[l, 0], 0.5)
        h = adaln_pre(x, mod[:, 1], norm_pre[l, 1])
        li = l // 2
        if l % 2 == 0:
            kp = None if sb_past is None else sb_past[li][0]
            vp = None if sb_past is None else sb_past[li][1]
            pb = None if pool_past is None else pool_past[li]
            y, k_new, v_new, buf = even_mixer(h, w_in_even[li], sb_bias[li], pool_w[li], pool_scale[li],
                                              w_out_even[li], kp, vp, pb)
            new_k.append(k_new)
            new_v.append(v_new)
            new_pool.append(buf)
        else:
            s0 = None if ret_past is None else ret_past[li]
            y, S = retention_mixer(h, w_in_odd[li], w_out_odd[li], s0, pos0)
            new_ret.append(S)
        x = adaln_post(x, y, mod[:, 1], norm_post[l, 1], 1.0)
        h = adaln_pre(x, mod[:, 2], norm_pre[l, 2])
        x = adaln_post(x, swiglu(h, ffn_w_in[l, 1], ffn_w_out[l, 1]), mod[:, 2], norm_post[l, 2], 0.5)
    return x, new_k, new_v, new_pool, new_ret


def setup_inputs(seed: int = 0) -> dict:
    key = jax.random.key(seed)
    ks = jax.random.split(key, 22)
    f32 = jnp.float32
    n_pages = PAST_LEN // PAGE_SIZE
    n_used = DEC_BATCH * n_pages
    n_phys = n_used + max(1, n_used // 4)
    nrm = lambda k, shape, s: jax.random.normal(k, shape, f32) * s
    page_table = jax.random.permutation(ks[8], n_phys)[:n_used].reshape(DEC_BATCH, n_pages).astype(jnp.int32)
    return {
        'x_prompt': nrm(ks[0], (BATCH, SEQ, D_MODEL), 1.0),
        'x_sample': nrm(ks[1], (DEC_BATCH, DEC_SEQ, D_MODEL), 1.0),
        'c_prompt': nrm(ks[2], (BATCH, D_MODEL), 1.0),
        'c_sample': nrm(ks[3], (DEC_BATCH, D_MODEL), 1.0),
        'cache_k': nrm(ks[4], (N_SB_LAYERS, n_phys, PAGE_SIZE, SB_HEADS, SB_HEAD_DIM), 1.0),
        'cache_v': nrm(ks[5], (N_SB_LAYERS, n_phys, PAGE_SIZE, SB_HEADS, SB_HEAD_DIM), 1.0),
        'state_pool': nrm(ks[6], (N_SB_LAYERS, DEC_BATCH, POOL_BUF, POOL_WIDTH), 1.0),
        'state_ret': nrm(ks[7], (N_RET_LAYERS, DEC_BATCH, RET_HEADS, RET_QK_DIM, RET_V_DIM), 0.5),
        'page_table': page_table,
        'w_ada': nrm(ks[9], (DEPTH, D_MODEL, N_SUB * 3 * D_MODEL), 0.5 * D_MODEL ** -0.5),
        'b_ada': nrm(ks[10], (DEPTH, N_SUB * 3 * D_MODEL), 0.01),
        'norm_pre': 1.0 + nrm(ks[11], (DEPTH, N_SUB, D_MODEL), 0.05),
        'norm_post': 1.0 + nrm(ks[12], (DEPTH, N_SUB, D_MODEL), 0.05),
        'ffn_w_in': nrm(ks[13], (DEPTH, 2, D_MODEL, 2 * D_FF), D_MODEL ** -0.5),
        'ffn_w_out': nrm(ks[14], (DEPTH, 2, D_FF, D_MODEL), D_FF ** -0.5),
        'w_in_even': nrm(ks[15], (N_SB_LAYERS, D_MODEL, EVEN_IN), D_MODEL ** -0.5),
        'sb_bias': SB_BIAS_INIT + nrm(ks[21], (N_SB_LAYERS, SB_HEADS), 0.1),
        'pool_w': nrm(ks[16], (N_SB_LAYERS, len(POOL_WINDOWS), POOL_GROUP, POOL_GROUP), POOL_GROUP ** -0.5),
        'pool_scale': 1.0 + nrm(ks[17], (N_SB_LAYERS, POOL_WIDTH), 0.1),
        'w_out_even': nrm(ks[18], (N_SB_LAYERS, EVEN_MIX, D_MODEL), EVEN_MIX ** -0.5),
        'w_in_odd': nrm(ks[19], (N_RET_LAYERS, D_MODEL, ODD_IN), D_MODEL ** -0.5),
        'w_out_odd': nrm(ks[20], (N_RET_LAYERS, RET_V_WIDTH, D_MODEL), RET_V_WIDTH ** -0.5),
    }


def reference(x_prompt, x_sample, c_prompt, c_sample, cache_k, cache_v, state_pool, state_ret,
              page_table, w_ada, b_ada, norm_pre, norm_post, ffn_w_in, ffn_w_out,
              w_in_even, sb_bias, pool_w, pool_scale, w_out_even, w_in_odd, w_out_odd):
    params = (w_ada, b_ada, norm_pre, norm_post, ffn_w_in, ffn_w_out,
              w_in_even, sb_bias, pool_w, pool_scale, w_out_even, w_in_odd, w_out_odd)
    db, n_pages = page_table.shape
    past_len = n_pages * cache_k.shape[2]
    y_prompt, kp, vp, pp, rp = run_trunk(x_prompt, c_prompt, None, None, None, 0, params)
    sb_past = []
    for li in range(N_SB_LAYERS):
        kg = cache_k[li][page_table].reshape(db, past_len, SB_HEADS, SB_HEAD_DIM)
        vg = cache_v[li][page_table].reshape(db, past_len, SB_HEADS, SB_HEAD_DIM)
        sb_past.append((kg, vg))
    pool_past = [state_pool[li] for li in range(N_SB_LAYERS)]
    ret_past = [state_ret[li] for li in range(N_RET_LAYERS)]
    y_sample, ks_, vs_, ps_, rs_ = run_trunk(x_sample, c_sample, sb_past, pool_past, ret_past, past_len, params)
    return (y_prompt, y_sample,
            jnp.stack(kp, 0), jnp.stack(vp, 0), jnp.stack(pp, 0), jnp.stack(rp, 0),
            jnp.stack(ks_, 0), jnp.stack(vs_, 0), jnp.stack(ps_, 0), jnp.stack(rs_, 0))
```

```cpp
#include <hip/hip_runtime.h>
#include <cstdio>
#include <cstdint>
namespace pg8 {
#define PG8_LAS __attribute__((address_space(3)))
typedef unsigned short bf16_t;
typedef short bf16x8 __attribute__((ext_vector_type(8)));
typedef float f32x4 __attribute__((ext_vector_type(4)));
typedef unsigned u32x4 __attribute__((ext_vector_type(4)));
constexpr int BM = 256, BK = 64, HALF = 128, HTB = HALF * BK * 2  , STAGE_BYTES = 8 * HTB, NXCD = 8, WGM = 8;

__host__ __device__ __forceinline__ int lds_byte(int r, int c) { const int st = (r >> 4) * 2 + (c >> 5), rr = r & 15, cc = c & 31, ob = rr * 64 + cc * 2; return st * 1024 + (ob ^ (((ob >> 9) & 1) << 5)); }
__host__ __device__ __forceinline__ void stage_rc(int b, int& R, int& C) { const int st = b / 1024, sb = b % 1024, swz = sb ^ (((sb >> 9) & 1) << 5); R = (st >> 1) * 16 + swz / 64; C = (st & 1) * 32 + (swz % 64) / 2; }
__host__ __device__ __forceinline__ int perm32(int rho) { const int n = rho >> 4, i = rho & 15; return 8 * (i >> 2) + 4 * n + (i & 3); }

struct Unit { int pm, pn; };
struct Gemm { const bf16_t* A; const bf16_t* Bt; int M, N, K; };

struct StaticOrder {
    int nM, nN, nwg, G, c;
    __host__ __device__ void init(int M, int N, int G_, int c_) { nM = M / BM; nN = N / BM; nwg = nM * nN; G = G_; c = c_; }
    __host__ __device__ bool next(int i, Unit& u) const {
        const long L = (long)i * G + c; if (L >= nwg) return false;
        int wgid = (int)L; { const int q = nwg / NXCD, r = nwg % NXCD, xcd = wgid % NXCD, off = wgid / NXCD; wgid = (xcd < r ? xcd * (q + 1) : r * (q + 1) + (xcd - r) * q) + off; }
        const int nig = WGM * nN, gid = wgid / nig, fm = gid * WGM, gsz = (nM - fm) < WGM ? (nM - fm) : WGM;
        u.pm = fm + ((wgid % nig) % gsz); u.pn = (wgid % nig) / gsz; return true;
    }
    __device__ __forceinline__ void a_ready(const Unit&) const {}
    __device__ __forceinline__ void done(const Unit&) const {}
};
__device__ __forceinline__ unsigned cvt_pk_bf16(float lo, float hi) { unsigned r; asm volatile("v_cvt_pk_bf16_f32 %0, %1, %2" : "=v"(r) : "v"(lo), "v"(hi)); return r; }
typedef unsigned u32x2 __attribute__((ext_vector_type(2)));
__device__ __forceinline__ float fast_rcp(float x) { return __builtin_amdgcn_rcpf(x); }
__device__ __forceinline__ float silu_f(float x) { return x * fast_rcp(1.0f + __builtin_amdgcn_exp2f(-1.4426950408889634f * x)); }

struct EpiMod {
    static constexpr bool PERM = false, AFTER_DRAIN = false;
    float* out; const float* b_ada; const float* norm_pre; const float* norm_post; int nrows;
    __device__ __forceinline__ void operator()(const f32x4 (&acc)[2][2][4][2], const Unit& u, int wr, int wc, int fr, int fq) const {
        const int ct = u.pn * BM; const int l = ct / 9216, cc0 = ct - l * 9216, sub = cc0 / 3072, j = (cc0 - sub * 3072) >> 10, d0 = cc0 & 1023;
        const float resw = (sub == 1) ? 1.0f : 0.5f;
#pragma unroll
        for (int bj = 0; bj < 2; ++bj)
#pragma unroll
            for (int n = 0; n < 2; ++n) {
                const int col = bj * HALF + wc * 32 + n * 16 + 4 * fq, gcol = ct + col, d = d0 + col;
                const f32x4 bias = *(const f32x4*)(b_ada + gcol);
                f32x4 gv = (f32x4){0.f, 0.f, 0.f, 0.f};
                if (j == 1) gv = *(const f32x4*)(norm_pre + (l * 3 + sub) * 1024 + d);
                if (j == 2) gv = *(const f32x4*)(norm_post + (l * 3 + sub) * 1024 + d) * resw;
#pragma unroll
                for (int ai = 0; ai < 2; ++ai)
#pragma unroll
                    for (int m = 0; m < 4; ++m) { const int row = ai * HALF + wr * 64 + m * 16 + fr;
                        f32x4 v = acc[ai][bj][m][n] + bias;
                        if (j == 1) v = gv * (v + 1.0f);
                        if (j == 2) v = gv * v;
                        if (row < nrows) *(f32x4*)(out + (size_t)row * 18432 + gcol) = v; }
            }
    }
};
struct EpiSwiGLU {
    static constexpr bool PERM = true, AFTER_DRAIN = false;
    bf16_t* G; int ldg;
    __device__ __forceinline__ void operator()(const f32x4 (&acc)[2][2][4][2], const Unit& u, int wr, int wc, int fr, int fq) const {
        const int col0 = u.pn * HALF + wc * 32 + 8 * fq;
#pragma unroll
        for (int ai = 0; ai < 2; ++ai)
#pragma unroll
            for (int m = 0; m < 4; ++m) { const int row = u.pm * BM + ai * HALF + wr * 64 + m * 16 + fr;
                float o[8];
#pragma unroll
                for (int n = 0; n < 2; ++n)
#pragma unroll
                    for (int e = 0; e < 4; ++e) o[n * 4 + e] = silu_f(acc[ai][0][m][n][e]) * acc[ai][1][m][n][e];
                u32x4 w; w.x = cvt_pk_bf16(o[0], o[1]); w.y = cvt_pk_bf16(o[2], o[3]); w.z = cvt_pk_bf16(o[4], o[5]); w.w = cvt_pk_bf16(o[6], o[7]);
                *(u32x4*)(G + (size_t)row * ldg + col0) = w; }
    }
};
struct EpiF32 {
    static constexpr bool PERM = false, AFTER_DRAIN = false;
    float* Y; int ldc;
    __device__ __forceinline__ void operator()(const f32x4 (&acc)[2][2][4][2], const Unit& u, int wr, int wc, int fr, int fq) const {
#pragma unroll
        for (int ai = 0; ai < 2; ++ai)
#pragma unroll
            for (int m = 0; m < 4; ++m) { float* rowp = Y + (size_t)(u.pm * BM + ai * HALF + wr * 64 + m * 16 + fr) * ldc + u.pn * BM + wc * 32 + 4 * fq;
#pragma unroll
                for (int bj = 0; bj < 2; ++bj)
#pragma unroll
                    for (int n = 0; n < 2; ++n) *(f32x4*)(rowp + bj * HALF + n * 16) = acc[ai][bj][m][n]; }
    }
};
struct EpiEvenIn {
    static constexpr bool PERM = false, AFTER_DRAIN = false;
    bf16_t *Q, *Kb, *Vb; float* U; float *kp, *vp, *ks, *vs; float qscale; int mp, mtot;
    __device__ __forceinline__ void operator()(const f32x4 (&acc)[2][2][4][2], const Unit& u, int wr, int wc, int fr, int fq) const {
        const int t = u.pn >> 1, c0 = (u.pn & 1) * BM + wc * 32 + 4 * fq;
#pragma unroll
        for (int ai = 0; ai < 2; ++ai)
#pragma unroll
            for (int m = 0; m < 4; ++m) { const int row = u.pm * BM + ai * HALF + wr * 64 + m * 16 + fr;
#pragma unroll
                for (int bj = 0; bj < 2; ++bj)
#pragma unroll
                    for (int n = 0; n < 2; ++n) { const int c = c0 + bj * HALF + n * 16; const f32x4 v = acc[ai][bj][m][n];
                        if (t == 0) { const f32x4 s = v * qscale; u32x2 w; w.x = cvt_pk_bf16(s[0], s[1]); w.y = cvt_pk_bf16(s[2], s[3]); *(u32x2*)(Q + (size_t)row * 512 + c) = w; }
                        else if (t == 3) { *(f32x4*)(U + (size_t)row * 512 + c) = v; }
                        else { u32x2 w; w.x = cvt_pk_bf16(v[0], v[1]); w.y = cvt_pk_bf16(v[2], v[3]); *(u32x2*)((t == 1 ? Kb : Vb) + (size_t)row * 512 + c) = w;
                            if (row < mp) *(f32x4*)((t == 1 ? kp : vp) + (size_t)row * 512 + c) = v;
                            else if (row < mtot) *(f32x4*)((t == 1 ? ks : vs) + (size_t)(row - mp) * 512 + c) = v; } }
            }
    }
};
struct EpiOddIn {
    static constexpr bool PERM = true, AFTER_DRAIN = false;
    bf16_t *Rq, *Rk, *Rv, *Rg; int mp;
    __device__ __forceinline__ void operator()(const f32x4 (&acc)[2][2][4][2], const Unit& u, int wr, int wc, int fr, int fq) const {
        const int i0 = wc * 32 + 8 * fq;
        if (u.pn < 8) {
            bf16_t* dst = (u.pn < 4 ? Rq : Rk) + (u.pn & 3) * 256; const float osc = (u.pn < 4) ? 1.0f : 0.0625f;
            float invr[8];
#pragma unroll
            for (int q = 0; q < 8; ++q) invr[q] = __builtin_amdgcn_exp2f(-(float)(i0 + q) * (13.287712379549449f / 128.0f)) * 0.15915494309189535f;
#pragma unroll
            for (int ai = 0; ai < 2; ++ai)
#pragma unroll
                for (int m = 0; m < 4; ++m) { const int row = u.pm * BM + ai * HALF + wr * 64 + m * 16 + fr; const float pos = (row < mp) ? (float)(row & 2047) : 2048.0f;
                    float o1[8], o2[8];
#pragma unroll
                    for (int q = 0; q < 8; ++q) { float rev = pos * invr[q]; rev = rev - __builtin_rintf(rev);
                        const float sn = __builtin_amdgcn_sinf(rev), cs = __builtin_amdgcn_cosf(rev);
                        const float x1 = acc[ai][0][m][q >> 2][q & 3], x2 = acc[ai][1][m][q >> 2][q & 3];
                        o1[q] = (x1 * cs - x2 * sn) * osc; o2[q] = (x1 * sn + x2 * cs) * osc; }
                    u32x4 w1, w2; w1.x = cvt_pk_bf16(o1[0], o1[1]); w1.y = cvt_pk_bf16(o1[2], o1[3]); w1.z = cvt_pk_bf16(o1[4], o1[5]); w1.w = cvt_pk_bf16(o1[6], o1[7]);
                    w2.x = cvt_pk_bf16(o2[0], o2[1]); w2.y = cvt_pk_bf16(o2[2], o2[3]); w2.z = cvt_pk_bf16(o2[4], o2[5]); w2.w = cvt_pk_bf16(o2[6], o2[7]);
                    *(u32x4*)(dst + (size_t)row * 1024 + i0) = w1; *(u32x4*)(dst + (size_t)row * 1024 + 128 + i0) = w2; }
        } else {
            const bool isg = u.pn >= 16; bf16_t* dst = (isg ? Rg : Rv) + ((u.pn - 8) & 7) * 256;
#pragma unroll
            for (int ai = 0; ai < 2; ++ai)
#pragma unroll
                for (int m = 0; m < 4; ++m) { const int row = u.pm * BM + ai * HALF + wr * 64 + m * 16 + fr;
#pragma unroll
                    for (int bj = 0; bj < 2; ++bj) { float o[8];
#pragma unroll
                        for (int q = 0; q < 8; ++q) { const float x = acc[ai][bj][m][q >> 2][q & 3]; o[q] = isg ? silu_f(x) : x; }
                        u32x4 w; w.x = cvt_pk_bf16(o[0], o[1]); w.y = cvt_pk_bf16(o[2], o[3]); w.z = cvt_pk_bf16(o[4], o[5]); w.w = cvt_pk_bf16(o[6], o[7]);
                        *(u32x4*)(dst + (size_t)row * 2048 + bj * HALF + i0) = w; } }
        }
    }
};
struct EpiPool {
    static constexpr bool PERM = true, AFTER_DRAIN = false;
    bf16_t* O; const float* pscale;
    __device__ __forceinline__ void operator()(const f32x4 (&acc)[2][2][4][2], const Unit& u, int wr, int wc, int fr, int fq) const {
#pragma unroll
        for (int bj = 0; bj < 2; ++bj) { const int c0 = u.pn * BM + bj * HALF + wc * 32 + 8 * fq;
            const f32x4 s0 = *(const f32x4*)(pscale + c0), s1 = *(const f32x4*)(pscale + c0 + 4);
#pragma unroll
            for (int ai = 0; ai < 2; ++ai)
#pragma unroll
                for (int m = 0; m < 4; ++m) { const int row = u.pm * BM + ai * HALF + wr * 64 + m * 16 + fr;
                    const f32x4 a = acc[ai][bj][m][0] * s0, b = acc[ai][bj][m][1] * s1;
                    u32x4 w; w.x = cvt_pk_bf16(a[0], a[1]); w.y = cvt_pk_bf16(a[2], a[3]); w.z = cvt_pk_bf16(b[0], b[1]); w.w = cvt_pk_bf16(b[2], b[3]);
                    *(u32x4*)(O + (size_t)row * 1024 + 512 + c0) = w; } }
    }
};
template <class Epi, class Sched, bool ALIGN_EPI = false, bool SP2 = false>
__device__ __forceinline__ void gemm_phase(PG8_LAS unsigned char* lds, const Gemm g, const Sched& S, const Epi& E) {
    int tid_ = threadIdx.x; asm volatile("" : "+v"(tid_));
    const int tid = tid_, wid = __builtin_amdgcn_readfirstlane(tid >> 6), lane = tid & 63, wr = wid >> 2, wc = wid & 3, fr = lane & 15, fq = lane >> 4;
    const int K = g.K, nt = K / BK;
    unsigned voffA[2], voffB[2];
#pragma unroll
    for (int i = 0; i < 2; ++i) { int R, C; stage_rc(tid * 16 + i * 8192, R, C); const int Rb = Epi::PERM ? ((R & ~31) + perm32(R & 31)) : R;
        voffA[i] = (unsigned)(R * K + C) * 2u; voffB[i] = (unsigned)(Rb * K + C) * 2u; }
    const size_t kstep = (size_t)(BK * 2);
    const size_t hstep = (size_t)HALF * K * 2;
    const size_t tstep = 2 * hstep;
    const unsigned ldsw = (unsigned)wid * 1024u;
    const int aoff = lds_byte(wr * 64 + fr, fq * 8), boff = lds_byte(wc * 32 + fr, fq * 8);
#define PG8_SA(b, h) (((b) * 2 + (h)) * HTB)
#define PG8_SB(b, h) ((4 + (b) * 2 + (h)) * HTB)
#define PG8_STAGE(bufoff, gbase, voff) do { _Pragma("unroll") for (int _i = 0; _i < 2; ++_i) \
        __builtin_amdgcn_global_load_lds((const unsigned*)((const char*)(gbase) + (voff)[_i]), (PG8_LAS unsigned*)(lds + (bufoff) + ldsw + _i * 8192), 16, 0, 0); } while (0)
#define PG8_LDA(dst, b, h) do { _Pragma("unroll") for (int m = 0; m < 4; ++m) _Pragma("unroll") for (int k = 0; k < 2; ++k) dst[m][k] = *(const PG8_LAS bf16x8*)(lds + PG8_SA(b, h) + aoff + m * 2048 + k * 1024); } while (0)
#define PG8_LDB(dst, b, h) do { _Pragma("unroll") for (int n = 0; n < 2; ++n) _Pragma("unroll") for (int k = 0; k < 2; ++k) dst[n][k] = *(const PG8_LAS bf16x8*)(lds + PG8_SB(b, h) + boff + n * 2048 + k * 1024); } while (0)
#define PG8_MMA(ai, bj, At, Bt) do { __builtin_amdgcn_s_setprio(1); _Pragma("unroll") for (int m = 0; m < 4; ++m) _Pragma("unroll") for (int n = 0; n < 2; ++n) _Pragma("unroll") for (int k = 0; k < 2; ++k) \
        acc[ai][bj][m][n] = __builtin_amdgcn_mfma_f32_16x16x32_bf16(Bt[n][k], At[m][k], acc[ai][bj][m][n], 0, 0, 0); __builtin_amdgcn_s_setprio(0); } while (0)
#define PG8_WAIT_V(n) asm volatile("s_waitcnt vmcnt(" #n ")" ::: "memory")
#define PG8_WAIT_L(n) asm volatile("s_waitcnt lgkmcnt(" #n ")" ::: "memory")
#define PG8_BAR __builtin_amdgcn_s_barrier()
#define PG8_SCHED __builtin_amdgcn_sched_barrier(0)
    Unit cur, nxt; int ui = 0;
    if (!S.next(0, cur)) return;
    f32x4 acc[2][2][4][2];
#pragma unroll
    for (int a = 0; a < 2; ++a)
#pragma unroll
        for (int b = 0; b < 2; ++b)
#pragma unroll
            for (int m = 0; m < 4; ++m)
#pragma unroll
                for (int n = 0; n < 2; ++n) acc[a][b][m][n] = (f32x4){0.f, 0.f, 0.f, 0.f};
    bf16x8 At[4][2], B0[2][2], B1[2][2];
    const char* cA = (const char*)g.A + (size_t)cur.pm * tstep; const char* cB = (const char*)g.Bt + (size_t)cur.pn * tstep;
    S.a_ready(cur);
    if constexpr (SP2) {
        PG8_STAGE(PG8_SB(0, 0), cB, voffB); PG8_STAGE(PG8_SB(0, 1), cB + hstep, voffB); PG8_STAGE(PG8_SA(0, 0), cA, voffA); PG8_STAGE(PG8_SA(0, 1), cA + hstep, voffA);
        if (wr == 1) PG8_BAR;
        PG8_WAIT_V(2); PG8_BAR;
        PG8_STAGE(PG8_SB(1, 0), cB + kstep, voffB); PG8_STAGE(PG8_SA(1, 0), cA + kstep, voffA); PG8_STAGE(PG8_SB(1, 1), cB + hstep + kstep, voffB);
        PG8_WAIT_V(6); PG8_BAR;
    } else {
        PG8_STAGE(PG8_SB(0, 0), cB, voffB); PG8_STAGE(PG8_SA(0, 0), cA, voffA); PG8_STAGE(PG8_SB(0, 1), cB + hstep, voffB); PG8_STAGE(PG8_SA(0, 1), cA + hstep, voffA);
        if (wr == 1) PG8_BAR;
        PG8_WAIT_V(4); PG8_BAR;
        PG8_STAGE(PG8_SB(1, 0), cB + kstep, voffB); PG8_STAGE(PG8_SA(1, 0), cA + kstep, voffA); PG8_STAGE(PG8_SB(1, 1), cB + hstep + kstep, voffB);
        PG8_WAIT_V(6); PG8_BAR;
    }
    for (;;) {
        const bool has_next = S.next(ui + 1, nxt);
        const char* nA = has_next ? (const char*)g.A + (size_t)nxt.pm * tstep : cA; const char* nB = has_next ? (const char*)g.Bt + (size_t)nxt.pn * tstep : cB;
        for (int t = 0; t < nt; t += 2) {
            const bool last = (t == nt - 2);
            const char* a1 = cA + (size_t)(t + 1) * kstep;
            const char* a2 = last ? nA : cA + (size_t)(t + 2) * kstep; const char* b2 = last ? nB : cB + (size_t)(t + 2) * kstep;
            const char* a3 = a2 + kstep; const char* b3 = b2 + kstep;
            if (last && has_next) S.a_ready(nxt);
            if constexpr (SP2) {
            PG8_LDB(B0, 0, 0); PG8_LDB(B1, 0, 1); PG8_SCHED; PG8_LDA(At, 0, 0); PG8_STAGE(PG8_SA(1, 1), a1 + hstep, voffA);
            PG8_WAIT_V(8); PG8_WAIT_L(0); PG8_BAR; PG8_MMA(0, 0, At, B0); PG8_MMA(0, 1, At, B1); PG8_BAR; PG8_SCHED;
            PG8_LDA(At, 0, 1); PG8_STAGE(PG8_SB(0, 0), b2, voffB); PG8_STAGE(PG8_SB(0, 1), b2 + hstep, voffB); PG8_STAGE(PG8_SA(0, 0), a2, voffA);
            PG8_WAIT_V(8); PG8_WAIT_L(0); PG8_BAR; PG8_MMA(1, 0, At, B0); PG8_MMA(1, 1, At, B1); PG8_BAR; PG8_SCHED;
            PG8_LDB(B0, 1, 0); PG8_LDB(B1, 1, 1); PG8_SCHED; PG8_LDA(At, 1, 0); PG8_STAGE(PG8_SA(0, 1), a2 + hstep, voffA);
            PG8_WAIT_V(8); PG8_WAIT_L(0); PG8_BAR; PG8_MMA(0, 0, At, B0); PG8_MMA(0, 1, At, B1); PG8_BAR; PG8_SCHED;
            PG8_LDA(At, 1, 1); PG8_STAGE(PG8_SB(1, 0), b3, voffB); PG8_STAGE(PG8_SB(1, 1), b3 + hstep, voffB); PG8_STAGE(PG8_SA(1, 0), a3, voffA);
            PG8_WAIT_V(8); PG8_WAIT_L(0); PG8_BAR; PG8_MMA(1, 0, At, B0); PG8_MMA(1, 1, At, B1); PG8_BAR; PG8_SCHED;
            } else {
            PG8_LDB(B0, 0, 0); PG8_SCHED; PG8_LDA(At, 0, 0); PG8_STAGE(PG8_SA(1, 1), a1 + hstep, voffA);
            PG8_WAIT_L(8); PG8_BAR; PG8_WAIT_L(0); PG8_MMA(0, 0, At, B0); PG8_BAR; PG8_SCHED;
            PG8_LDB(B1, 0, 1); PG8_STAGE(PG8_SB(0, 0), b2, voffB);
            PG8_BAR; PG8_WAIT_L(0); PG8_MMA(0, 1, At, B1); PG8_BAR;
            PG8_LDA(At, 0, 1); PG8_STAGE(PG8_SA(0, 0), a2, voffA);
            PG8_BAR; PG8_WAIT_L(0); PG8_MMA(1, 0, At, B0); PG8_BAR; PG8_SCHED;
            PG8_STAGE(PG8_SB(0, 1), b2 + hstep, voffB);
            PG8_WAIT_V(6); PG8_BAR; PG8_MMA(1, 1, At, B1); PG8_BAR;
            PG8_LDB(B0, 1, 0); PG8_SCHED; PG8_LDA(At, 1, 0); PG8_STAGE(PG8_SA(0, 1), a2 + hstep, voffA);
            PG8_WAIT_L(8); PG8_BAR; PG8_WAIT_L(0); PG8_MMA(0, 0, At, B0); PG8_BAR; PG8_SCHED;
            PG8_LDB(B1, 1, 1); PG8_STAGE(PG8_SB(1, 0), b3, voffB);
            PG8_BAR; PG8_WAIT_L(0); PG8_MMA(0, 1, At, B1); PG8_BAR;
            PG8_LDA(At, 1, 1); PG8_STAGE(PG8_SA(1, 0), a3, voffA);
            PG8_BAR; PG8_WAIT_L(0); PG8_MMA(1, 0, At, B0); PG8_BAR; PG8_SCHED;
            PG8_STAGE(PG8_SB(1, 1), b3 + hstep, voffB);
            PG8_WAIT_V(6); PG8_BAR; PG8_MMA(1, 1, At, B1); PG8_BAR;
            }
        }
        if constexpr (ALIGN_EPI) { if (wr == 0) PG8_BAR; }
        if constexpr (!Epi::AFTER_DRAIN) { E(acc, cur, wr, wc, fr, fq); S.done(cur); }
        if (!has_next) break;
#pragma unroll
        for (int a = 0; a < 2; ++a)
#pragma unroll
            for (int b = 0; b < 2; ++b)
#pragma unroll
                for (int m = 0; m < 4; ++m)
#pragma unroll
                    for (int n = 0; n < 2; ++n) acc[a][b][m][n] = (f32x4){0.f, 0.f, 0.f, 0.f};
        cur = nxt; cA = nA; cB = nB; ++ui;
        if constexpr (ALIGN_EPI) { if (wr == 1) PG8_BAR; }
    }
    PG8_WAIT_V(0);
    if constexpr (!ALIGN_EPI) { if (wr == 0) PG8_BAR; }
    PG8_BAR;
    if constexpr (Epi::AFTER_DRAIN) { E.fused(acc, cur, wr, wc, fr, fq, lds, wid, lane); S.done(cur); }
#undef PG8_SA
#undef PG8_SB
#undef PG8_STAGE
#undef PG8_LDA
#undef PG8_LDB
#undef PG8_MMA
#undef PG8_WAIT_V
#undef PG8_WAIT_L
#undef PG8_BAR
#undef PG8_SCHED
}
}
constexpr int NWAVES = 8;
constexpr int DM = 1024, NB_P = 8, TSEQ = 2048, NB_S = 128, NB_TOT = NB_P + NB_S;
constexpr int MP = NB_P * TSEQ;
constexpr int MR = MP + NB_S;
constexpr int MPAD = 16640;
constexpr int DFF = 2816, NPAGES = 16, PAGE = 128, NPHYS = 2560;
constexpr float NORM_EPS = 1e-6f;
constexpr float LOG2E = 1.4426950408889634f;
enum { I_XP = 0, I_XS, I_CP, I_CS, I_CK, I_CV, I_SPOOL, I_SRET, I_PT, I_WADA, I_BADA, I_NPRE, I_NPOST, I_FIN, I_FOUT, I_WIE, I_SBB, I_PW, I_PS, I_WOE, I_WIO, I_WOO, N_IN };
constexpr size_t O_Y = 0, O_KP = 16908288, O_VP = 25296896, O_POOLP = 33685504, O_RETP = 33746944, O_KS = 37941248, O_VS = 38006784, O_POOLS = 38072320, O_RETS = 39055360, O_END = 106164224;

constexpr size_t MiB = 1u << 20;
constexpr size_t al(size_t x) { return (x + 4095) & ~(size_t)4095; }
constexpr size_t WS_CTL = 0, CTL_ZERO_BYTES = 1 * MiB;
constexpr size_t WS_WADA = 2 * MiB;
constexpr size_t WS_WFIN = WS_WADA + al((size_t)18432 * 1024 * 2);
constexpr size_t WFIN_SZ = (size_t)5632 * 1024 * 2;
constexpr size_t WS_WFOUT = WS_WFIN + 4 * WFIN_SZ;
constexpr size_t WFOUT_SZ = (size_t)1024 * 2816 * 2;
constexpr size_t WS_WEI = WS_WFOUT + 4 * WFOUT_SZ;
constexpr size_t WS_WEO = WS_WEI + (size_t)2048 * 1024 * 2;
constexpr size_t WS_WPOOL = WS_WEO + (size_t)1024 * 1024 * 2;
constexpr size_t WS_WOI = WS_WPOOL + (size_t)512 * 512 * 2;
constexpr size_t WS_WOO = WS_WOI + (size_t)6144 * 1024 * 2;
constexpr size_t WS_COND = WS_WOO + (size_t)1024 * 2048 * 2;
constexpr size_t WS_MODT = WS_COND + (size_t)256 * 1024 * 2;
constexpr size_t WS_H = al(WS_MODT + (size_t)NB_TOT * 18432 * 4);
constexpr size_t WS_G = WS_H + (size_t)MPAD * 1024 * 2;
constexpr size_t WS_Y = WS_G + (size_t)MPAD * 2816 * 2;
constexpr size_t WS_Q = WS_Y + (size_t)MPAD * 1024 * 4;
constexpr size_t WS_KB = WS_Q + (size_t)MPAD * 512 * 2;
constexpr size_t WS_VB = WS_KB + (size_t)MPAD * 512 * 2;
constexpr size_t WS_U = WS_VB + (size_t)MPAD * 512 * 2;
constexpr size_t WS_D = WS_U + (size_t)MPAD * 512 * 4;
constexpr size_t WS_O = WS_D + (size_t)MPAD * 512 * 2;
constexpr size_t WS_RQ = WS_O + (size_t)MPAD * 1024 * 2;
constexpr size_t WS_RK = WS_RQ + (size_t)MPAD * 1024 * 2;
constexpr size_t WS_RV = WS_RK + (size_t)MPAD * 1024 * 2;
constexpr size_t WS_RG = WS_RV + (size_t)MPAD * 2048 * 2;
constexpr size_t WS_RO = WS_RG + (size_t)MPAD * 2048 * 2;
constexpr size_t WS_SBP = WS_RO + (size_t)MPAD * 2048 * 2;
constexpr size_t WS_END = al(WS_SBP + (size_t)128 * 2 * 8 * 80 * 4);
constexpr int CW_TMO = 0, CW_CODE = 1;
constexpr int CW_BAR = 4096;

constexpr int RING_OFF = 0, RING_BYTES = 155648;
constexpr int LDSCTL_OFF = RING_BYTES, MISC_OFF = LDSCTL_OFF + 320;
constexpr int LDS_BYTES = 156672;
static_assert(MISC_OFF + 128 <= LDS_BYTES, "LDS map");

#define GAS __attribute__((address_space(1)))
#define LAS __attribute__((address_space(3)))
typedef unsigned short bf16;
typedef unsigned v4u __attribute__((ext_vector_type(4)));
typedef unsigned v2u __attribute__((ext_vector_type(2)));
typedef float f32x4 __attribute__((ext_vector_type(4)));
typedef float f32x16 __attribute__((ext_vector_type(16)));
typedef short bf16x8 __attribute__((ext_vector_type(8)));
typedef short s16x4 __attribute__((ext_vector_type(4)));
typedef GAS unsigned gu32;
#define RLX_AGENT __ATOMIC_RELAXED, __HIP_MEMORY_SCOPE_AGENT
#define LDS_WAIT() asm volatile("s_waitcnt lgkmcnt(0)" ::: "memory")
#define VM_WAIT() asm volatile("s_waitcnt vmcnt(0)" ::: "memory")
__device__ __forceinline__ unsigned f2bf(float f) { unsigned u = __builtin_bit_cast(unsigned, f); return (u + 0x7fffu + ((u >> 16) & 1u)) >> 16; }
__device__ __forceinline__ unsigned pk2(float lo, float hi) { return f2bf(lo) | (f2bf(hi) << 16); }
__device__ __forceinline__ float bf2f(unsigned short h) { return __builtin_bit_cast(float, (unsigned)h << 16); }
__device__ __forceinline__ float bflo(unsigned w) { return __builtin_bit_cast(float, w << 16); }
__device__ __forceinline__ float bfhi(unsigned w) { return __builtin_bit_cast(float, w & 0xffff0000u); }
__device__ __forceinline__ float wave_sum(float v) {
#pragma unroll
    for (int o = 1; o < 64; o <<= 1) v += __shfl_xor(v, o);
    return v;
}
#define XB_TMO      128
#define XB_XCNT(j)  (256  + 64 * (j))
#define XB_XSUB(j)  (1280 + 64 * (j))
#define XB_XGEN(j)  (2304 + 64 * (j))
#define XB_TOP      3328
#define XB_TOPGEN   3392
#define XCD_BAR_WORDS 3456
#define XB_SPIN_CAP (1u << 18)

__device__ __forceinline__ unsigned xb_ld(unsigned* p)              { return __hip_atomic_load(p, __ATOMIC_RELAXED, __HIP_MEMORY_SCOPE_AGENT); }
__device__ __forceinline__ unsigned xb_add(unsigned* p, unsigned v) { return __hip_atomic_fetch_add(p, v, __ATOMIC_RELAXED, __HIP_MEMORY_SCOPE_AGENT); }
__device__ __forceinline__ unsigned xb_xcc_id() { return (unsigned)__builtin_amdgcn_s_getreg((3 << 11) | 20) & 0xFu; }
#define XB_SPIN(cond, bar) do { unsigned _sp = 0; while (cond) { __builtin_amdgcn_s_sleep(1); \
    if ((++_sp & 255u) == 0u) { if (xb_ld(&(bar)[XB_TMO])) break; if (_sp > XB_SPIN_CAP) { atomicAdd(&(bar)[XB_TMO], 1u); break; } } } } while (0)

struct XcdBarrier {
    unsigned* bar; unsigned x;
    volatile LAS unsigned* st;
};

__device__ __forceinline__ XcdBarrier xcd_barrier_post(unsigned* bar, volatile LAS unsigned* st) {
    XcdBarrier b; b.bar = bar; b.x = xb_xcc_id(); b.st = st;
    if (threadIdx.x == 0) (void)xb_add(&bar[XB_XCNT(b.x)], 1u);
    return b;
}
__device__ __forceinline__ void xcd_barrier_complete(unsigned* bar, unsigned x, unsigned& nloc, unsigned& nx) {
    const unsigned G = gridDim.x * gridDim.y * gridDim.z;
    unsigned sum, cnt, mine, sp = 0u;
    for (;;) {
        sum = 0u; cnt = 0u; mine = 0u;
#pragma unroll
        for (unsigned j = 0; j < 16; ++j) { const unsigned c = xb_ld(&bar[XB_XCNT(j)]); sum += c; cnt += (c > 0u) ? 1u : 0u; mine = (j == x) ? c : mine; }
        if (sum == G) break;
        __builtin_amdgcn_s_sleep(1);
        if ((++sp & 255u) == 0u) { if (xb_ld(&bar[XB_TMO])) break; if (sp > XB_SPIN_CAP) { atomicAdd(&bar[XB_TMO], 1u); break; } }
    }
    nloc = mine > 0u ? mine : 1u; nx = cnt > 0u ? cnt : 1u;
}

__device__ __forceinline__ void xcd_barrier(const XcdBarrier& b) {
    asm volatile("s_waitcnt vmcnt(0)" ::: "memory");
    __syncthreads();
    if (threadIdx.x == 0) {
        unsigned* bar = b.bar;
        __builtin_amdgcn_s_waitcnt(0);
        unsigned nloc = b.st[0], nx = b.st[1];
        if (nloc == 0u) { xcd_barrier_complete(bar, b.x, nloc, nx); b.st[0] = nloc; b.st[1] = nx; }
        const unsigned old = xb_add(&bar[XB_XSUB(b.x)], 1u);
        const unsigned gen = old / nloc;
        if (old + 1u == (gen + 1u) * nloc) {
            __builtin_amdgcn_fence(__ATOMIC_RELEASE, "agent");
            asm volatile("s_waitcnt vmcnt(0)" ::: "memory");
            const unsigned og = xb_add(&bar[XB_TOP], 1u);
            const unsigned tg = og / nx;
            if (og + 1u == (tg + 1u) * nx) xb_add(&bar[XB_TOPGEN], 1u);
            else XB_SPIN(xb_ld(&bar[XB_TOPGEN]) == tg, bar);
            __builtin_amdgcn_fence(__ATOMIC_ACQUIRE, "agent");
            xb_add(&bar[XB_XGEN(b.x)], 1u);
            asm volatile("s_waitcnt vmcnt(0)" ::: "memory");
        } else {
            XB_SPIN(xb_ld(&bar[XB_XGEN(b.x)]) == gen, bar);
            __builtin_amdgcn_fence(__ATOMIC_ACQUIRE, "agent");
            asm volatile("s_waitcnt vmcnt(0)" ::: "memory");
        }
    }
    __syncthreads();
}
struct Frame {
    LAS unsigned char* lds;
    volatile LAS unsigned* MISC;
    gu32* ctl;
    int tid, lane, wave;
    int G;
    float* out;
    unsigned char* ws;
};
struct Args { const float* in[N_IN]; float* out; unsigned char* ws; int ph_lo, ph_hi; };
#define KARG ((const __attribute__((address_space(4))) Args*)__builtin_amdgcn_kernarg_segment_ptr())
#define INP(i) (KARG->in[i])
#define WSP(T, off) ((T*)(F.ws + (off)))

__device__ __forceinline__ void tr_item(const float* Wblk, int ldw, bf16* WTblk, int ldwt, LAS float* scr, int lane, bool zero) {
#pragma unroll 8
    for (int i = 0; i < 32; ++i) { const int kk = 2 * i + (lane >> 5); scr[kk * 33 + (lane & 31)] = zero ? 0.f : Wblk[(size_t)kk * ldw + (lane & 31)]; }
    LDS_WAIT(); asm volatile("" ::: "memory");
    const int c = lane & 7;
#pragma unroll
    for (int j = 0; j < 4; ++j) { const int n = (lane >> 3) + 8 * j; const LAS float* s = scr + (8 * c) * 33 + n;
        v4u o; o.x = pk2(s[0 * 33], s[1 * 33]); o.y = pk2(s[2 * 33], s[3 * 33]); o.z = pk2(s[4 * 33], s[5 * 33]); o.w = pk2(s[6 * 33], s[7 * 33]);
        *(GAS v4u*)(WTblk + (size_t)n * ldwt + 8 * c) = o; }
    LDS_WAIT(); asm volatile("" ::: "memory");
}
__device__ __forceinline__ void tr_plain(const float* W, int K, int N, bf16* WT, LAS float* scr, int item, int lane) {
    const int nblk = N / 32, kb = item / nblk, nb = item - kb * nblk;
    tr_item(W + (size_t)(64 * kb) * N + 32 * nb, N, WT + (size_t)(32 * nb) * K + 64 * kb, K, scr, lane, false);
}
__device__ __forceinline__ void p0_prologue(Frame& F) {
    LAS float* scr = (LAS float*)(F.lds + RING_OFF + F.wave * 16384);
    const int gw = blockIdx.x * NWAVES + F.wave, NGW = F.G * NWAVES;
    constexpr int IT_ADA = 16 * 288, IT_FIN = 16 * 176, IT_FOUT = 44 * 32, IT_EI = 16 * 64, IT_EO = 16 * 32, IT_OI = 16 * 192, IT_OO = 32 * 32, IT_PW = 8 * 16;
    constexpr int NITEMS = 2 * IT_ADA + 4 * IT_FIN + 4 * IT_FOUT + IT_EI + IT_EO + IT_OI + IT_OO + IT_PW;
    for (int it = gw; it < NITEMS; it += NGW) {
        int r = it;
        if (r < 2 * IT_ADA) { const int l = r / IT_ADA; r -= l * IT_ADA; tr_plain(INP(I_WADA) + (size_t)l * 1024 * 9216, 1024, 9216, WSP(bf16, WS_WADA) + (size_t)l * 9216 * 1024, scr, r, F.lane); continue; } r -= 2 * IT_ADA;
        if (r < 4 * IT_FIN) { const int lf = r / IT_FIN; r -= lf * IT_FIN;
            const int kb = r / 176, nb = r - kb * 176, n0 = 32 * nb; const int up = n0 >= DFF, j0 = up ? n0 - DFF : n0; const int row0 = 256 * (j0 >> 7) + 128 * up + (j0 & 127);
            tr_item(INP(I_FIN) + (size_t)lf * 1024 * 5632 + (size_t)(64 * kb) * 5632 + n0, 5632, WSP(bf16, WS_WFIN + lf * WFIN_SZ) + (size_t)row0 * 1024 + 64 * kb, 1024, scr, F.lane, false); continue; } r -= 4 * IT_FIN;
        if (r < 4 * IT_FOUT) { const int lf = r / IT_FOUT; r -= lf * IT_FOUT; tr_plain(INP(I_FOUT) + (size_t)lf * 2816 * 1024, 2816, 1024, WSP(bf16, WS_WFOUT + lf * WFOUT_SZ), scr, r, F.lane); continue; } r -= 4 * IT_FOUT;
        if (r < IT_EI) { tr_plain(INP(I_WIE), 1024, 2048, WSP(bf16, WS_WEI), scr, r, F.lane); continue; } r -= IT_EI;
        if (r < IT_EO) { tr_plain(INP(I_WOE), 1024, 1024, WSP(bf16, WS_WEO), scr, r, F.lane); continue; } r -= IT_EO;
        if (r < IT_OI) { tr_plain(INP(I_WIO), 1024, 6144, WSP(bf16, WS_WOI), scr, r, F.lane); continue; } r -= IT_OI;
        if (r < IT_OO) { tr_plain(INP(I_WOO), 2048, 1024, WSP(bf16, WS_WOO), scr, r, F.lane); continue; } r -= IT_OO;
        {
            const int kb = r / 16, nb = r - kb * 16, k0 = 64 * kb, n0 = 32 * nb, gk = k0 >> 7, gn = n0 >> 7;
            tr_item(INP(I_PW) + (size_t)gk * 16384 + (size_t)(k0 & 127) * 128 + (n0 & 127), 128, WSP(bf16, WS_WPOOL) + (size_t)n0 * 512 + k0, 512, scr, F.lane, gk != gn); }
    }
    for (int row = gw; row < 256; row += NGW) {
        const float* src = row < NB_P ? INP(I_CP) + (size_t)row * 1024 : INP(I_CS) + (size_t)(row - NB_P) * 1024;
        GAS unsigned long long* o8 = (GAS unsigned long long*)(WSP(bf16, WS_COND) + (size_t)row * 1024) + F.lane;
#pragma unroll
        for (int j = 0; j < 4; ++j) { f32x4 v = (f32x4){0.f, 0.f, 0.f, 0.f}; if (row < NB_TOT) v = *((const GAS f32x4*)src + F.lane + 64 * j);
            float s[4];
#pragma unroll
            for (int e = 0; e < 4; ++e) s[e] = v[e] / (1.0f + __expf(-v[e]));
            o8[64 * j] = (unsigned long long)pk2(s[0], s[1]) | ((unsigned long long)pk2(s[2], s[3]) << 32); }
    }
}

__device__ __forceinline__ void seam_phase(Frame& F, bool first, bool has_y, bool has_h, int gate_off, int pre_off) {
    const int gw = blockIdx.x * NWAVES + F.wave, NGW = F.G * NWAVES;
    const float* MT = WSP(const float, WS_MODT); const float* Y = WSP(const float, WS_Y); bf16* H = WSP(bf16, WS_H); float* X = F.out + O_Y;
    for (int r = gw; r < MR; r += NGW) {
        const int b = r < MP ? (r >> 11) : NB_P + (r - MP);
        const float* T = MT + (size_t)b * 18432;
        const float* xrow = first ? (r < MP ? INP(I_XP) + (size_t)r * 1024 : INP(I_XS) + (size_t)(r - MP) * 1024) : X + (size_t)r * 1024;
        f32x4 x[4];
#pragma unroll
        for (int j = 0; j < 4; ++j) x[j] = *((const GAS f32x4*)xrow + F.lane + 64 * j);
        if (has_y) {
            f32x4 y[4]; float s = 0.f;
#pragma unroll
            for (int j = 0; j < 4; ++j) { y[j] = *((const GAS f32x4*)(Y + (size_t)r * 1024) + F.lane + 64 * j); s += (y[j].x * y[j].x + y[j].y * y[j].y) + (y[j].z * y[j].z + y[j].w * y[j].w); }
            const float rs = 1.0f / sqrtf(wave_sum(s) * (1.0f / 1024.0f) + NORM_EPS);
#pragma unroll
            for (int j = 0; j < 4; ++j) { const f32x4 g = *((const GAS f32x4*)(T + gate_off + 2048) + F.lane + 64 * j); x[j] = x[j] + g * y[j] * rs;
                *((GAS f32x4*)(X + (size_t)r * 1024) + F.lane + 64 * j) = x[j]; }
        }
        if (has_h) {
            float s = 0.f;
#pragma unroll
            for (int j = 0; j < 4; ++j) s += (x[j].x * x[j].x + x[j].y * x[j].y) + (x[j].z * x[j].z + x[j].w * x[j].w);
            const float rs = 1.0f / sqrtf(wave_sum(s) * (1.0f / 1024.0f) + NORM_EPS);
            GAS unsigned long long* o8 = (GAS unsigned long long*)(H + (size_t)r * 1024) + F.lane;
#pragma unroll
            for (int j = 0; j < 4; ++j) { const f32x4 sh = *((const GAS f32x4*)(T + pre_off) + F.lane + 64 * j), sc = *((const GAS f32x4*)(T + pre_off + 1024) + F.lane + 64 * j);
                const f32x4 h = x[j] * rs * sc + sh;
                o8[64 * j] = (unsigned long long)pk2(h.x, h.y) | ((unsigned long long)pk2(h.z, h.w) << 32); }
        }
    }
}
#define MFMA32(a, b, c) __builtin_amdgcn_mfma_f32_32x32x16_bf16((a), (b), (c), 0, 0, 0)
typedef float f32x2 __attribute__((ext_vector_type(2)));
typedef __bf16 bf16v2 __attribute__((ext_vector_type(2)));
__device__ __forceinline__ unsigned pkbf(float a, float b) { f32x2 v = {a, b}; bf16v2 r = __builtin_convertvector(v, bf16v2); return __builtin_bit_cast(unsigned, r); }
__device__ __forceinline__ bf16x8 pack8(float a0, float a1, float a2, float a3, float a4, float a5, float a6, float a7) {
    v4u p; p.x = pkbf(a0, a1); p.y = pkbf(a2, a3); p.z = pkbf(a4, a5); p.w = pkbf(a6, a7); return __builtin_bit_cast(bf16x8, p); }
__device__ __forceinline__ int crow(int i, int hb) { return (i & 3) + 8 * (i >> 2) + 4 * hb; }
__device__ __forceinline__ s16x4 tr_read(const LAS unsigned char* p) { return __builtin_amdgcn_ds_read_tr16_b64_v4i16((LAS s16x4*)p); }
__device__ __forceinline__ bf16x8 tr_pair(const LAS unsigned char* lo, const LAS unsigned char* hi) { const s16x4 a = tr_read(lo), b = tr_read(hi); return __builtin_shufflevector(a, b, 0, 1, 2, 3, 4, 5, 6, 7); }
__device__ __forceinline__ float partner32(float x, int hb) {
    const unsigned u = __builtin_bit_cast(unsigned, x);
    auto r = __builtin_amdgcn_permlane32_swap(u, u, false, false);
    return __builtin_bit_cast(float, hb ? r[0] : r[1]);
}
template <class T> __device__ __forceinline__ T gld(const void* ubase, unsigned voff) { return *(const GAS T*)((const GAS char*)ubase + voff); }
template <class T> __device__ __forceinline__ void gst(void* ubase, unsigned voff, T v) { *(GAS T*)((GAS char*)ubase + voff) = v; }
#define WG_BAR() do { asm volatile("s_waitcnt lgkmcnt(0)" ::: "memory"); __builtin_amdgcn_s_barrier(); asm volatile("" ::: "memory"); } while (0)

constexpr int SB_PITCH = 144;
constexpr int SB_TILE = 64 * SB_PITCH;
template <bool DIAG>
__device__ __forceinline__ void sb_subtile(const LAS unsigned char* Kt, const LAS unsigned char* Vt, int sub, const bf16x8 (&qf)[4], float biasl2, float& C, f32x16 (&o)[2], int lane) {
    const int r32 = lane & 31, hb = lane >> 5;
    f32x16 acc;
#pragma unroll
    for (int i = 0; i < 16; ++i) acc[i] = biasl2;
#pragma unroll
    for (int c = 0; c < 4; ++c) { const bf16x8 kf = *(const LAS bf16x8*)(Kt + (32 * sub + r32) * SB_PITCH + 32 * c + 16 * hb); acc = MFMA32(kf, qf[c], acc); }
    float r[16], be[16];
#pragma unroll
    for (int i = 0; i < 16; ++i) { const float e = __builtin_amdgcn_exp2f(__builtin_fminf(acc[i], 100.0f)); r[i] = __builtin_amdgcn_rcpf(1.0f + e); be[i] = e * r[i];
        if (DIAG) { if (crow(i, hb) >= r32) { r[i] = 1.0f; be[i] = 0.0f; } } }
    float sfx[16], T[4], Tp[4];
#pragma unroll
    for (int g = 0; g < 4; ++g) { const float a0 = r[4 * g], a1 = r[4 * g + 1], a2 = r[4 * g + 2], a3 = r[4 * g + 3];
        sfx[4 * g + 3] = 1.0f; sfx[4 * g + 2] = a3; const float s1 = a2 * a3; sfx[4 * g + 1] = s1; const float s0 = a1 * s1; sfx[4 * g] = s0; T[g] = a0 * s0; Tp[g] = partner32(T[g], hb); }
    const float p3 = T[3] * Tp[3], p2 = T[2] * Tp[2], p1 = T[1] * Tp[1], p0 = T[0] * Tp[0];
    float suf[4]; suf[3] = 1.0f; suf[2] = p3; suf[1] = p2 * p3; suf[0] = p1 * suf[1]; const float tot = p0 * suf[0];
    float w[16];
#pragma unroll
    for (int g = 0; g < 4; ++g) { const float off = C * suf[g] * (hb == 0 ? Tp[g] : 1.0f);
#pragma unroll
        for (int e = 0; e < 4; ++e) w[4 * g + e] = be[4 * g + e] * sfx[4 * g + e] * off; }
    C *= tot;
    const int q4 = (lane & 15) >> 2, p4 = lane & 3, blk = (lane >> 4) & 1;
#pragma unroll
    for (int s = 0; s < 2; ++s) { const bf16x8 xs = pack8(w[8 * s], w[8 * s + 1], w[8 * s + 2], w[8 * s + 3], w[8 * s + 4], w[8 * s + 5], w[8 * s + 6], w[8 * s + 7]);
#pragma unroll
        for (int dh = 0; dh < 2; ++dh) { const LAS unsigned char* a = Vt + (32 * sub + 16 * s + 4 * hb + q4) * SB_PITCH + (32 * dh + 16 * blk) * 2 + 8 * p4;
            const bf16x8 pb = tr_pair(a, a + 8 * SB_PITCH); o[dh] = MFMA32(xs, pb, o[dh]); } }
}
__device__ __forceinline__ void sb_prompt_unit(Frame& F, int bh, int qb) {
#ifdef STUB_SBP
    return;
#endif
    const int b = bh >> 3, h = bh & 7, w = F.wave, lane = F.lane, tid = F.tid, r32 = lane & 31, hb = lane >> 5;
    const bf16* Q = WSP(const bf16, WS_Q); const bf16* Kb = WSP(const bf16, WS_KB); const bf16* Vb = WSP(const bf16, WS_VB); bf16* O = WSP(bf16, WS_O);
    const int t0 = 256 * qb; const size_t rowb = (size_t)b * TSEQ;
    bf16x8 qf[4];
    { const bf16* qub = Q + (rowb + t0 + 32 * w) * 512 + h * 64; const unsigned qoff = (unsigned)(r32 * 512 + 8 * hb) * 2u;
#pragma unroll
      for (int c = 0; c < 4; ++c) qf[c] = gld<bf16x8>(qub + 16 * c, qoff); }
    const float biasl2 = INP(I_SBB)[h] * LOG2E;
    f32x16 o[2];
#pragma unroll
    for (int i = 0; i < 16; ++i) { o[0][i] = 0.f; o[1][i] = 0.f; }
    float C = 1.0f;
    const int jmax = 4 * qb + 3, jd = 4 * qb + (w >> 1);
    const int kr = tid >> 3, pc = tid & 7;
    const bf16* kub = Kb + rowb * 512 + h * 64; const bf16* vub = Vb + rowb * 512 + h * 64; const unsigned kvoff = (unsigned)(kr * 512 + pc * 8) * 2u;
    v4u kreg = gld<v4u>(kub + (size_t)jmax * 64 * 512, kvoff), vreg = gld<v4u>(vub + (size_t)jmax * 64 * 512, kvoff);
    LAS unsigned char* base = F.lds + RING_OFF;
    WG_BAR();
    for (int j = jmax; j >= 0; --j) {
        LAS unsigned char* Kt = base + (j & 1) * (2 * SB_TILE); LAS unsigned char* Vt = Kt + SB_TILE;
        *(LAS v4u*)(Kt + kr * SB_PITCH + pc * 16) = kreg; *(LAS v4u*)(Vt + kr * SB_PITCH + pc * 16) = vreg;
        if (j > 0) { kreg = gld<v4u>(kub + (size_t)(j - 1) * 64 * 512, kvoff); vreg = gld<v4u>(vub + (size_t)(j - 1) * 64 * 512, kvoff); }
        WG_BAR();
        if (j < jd) { sb_subtile<false>(Kt, Vt, 1, qf, biasl2, C, o, lane); sb_subtile<false>(Kt, Vt, 0, qf, biasl2, C, o, lane); }
        else if (j == jd) {
            if (w & 1) { sb_subtile<true>(Kt, Vt, 1, qf, biasl2, C, o, lane); sb_subtile<false>(Kt, Vt, 0, qf, biasl2, C, o, lane); }
            else sb_subtile<true>(Kt, Vt, 0, qf, biasl2, C, o, lane);
        }
    }
    bf16* oub = O + (rowb + t0 + 32 * w) * 1024 + h * 64; const unsigned ooff = (unsigned)(4 * hb * 1024 + r32) * 2u;
#pragma unroll
    for (int dh = 0; dh < 2; ++dh)
#pragma unroll
        for (int i = 0; i < 16; ++i) gst<bf16>(oub + (size_t)crow(i, 0) * 1024 + 32 * dh, ooff, (bf16)f2bf(o[dh][i]));
}

__device__ __forceinline__ void sb_sample_unit(Frame& F, int b, int half) {
#ifdef STUB_SBS
    return;
#endif
    const int h = F.wave, lane = F.lane, d4 = lane & 15, sub = lane >> 4;
    const float* ck = INP(I_CK); const float* cv = INP(I_CV); const int* pt = (const int*)INP(I_PT);
    const bf16* Q = WSP(const bf16, WS_Q);
    const v2u qraw = *(const GAS v2u*)(Q + (size_t)(MP + b) * 512 + h * 64 + 4 * d4);
    const f32x4 qv = {bflo(qraw.x), bfhi(qraw.x), bflo(qraw.y), bfhi(qraw.y)};
    const float biasl2 = INP(I_SBB)[h] * LOG2E;
    f32x4 oacc = {0.f, 0.f, 0.f, 0.f}; float C = 1.0f;
    for (int pg = half * 8 + 7; pg >= half * 8; --pg) {
        const size_t pbase = (size_t)pt[b * NPAGES + pg] * (PAGE * 512) + h * 64 + 4 * d4;
        const float* kp = ck + pbase; const float* vp = cv + pbase;
#pragma unroll 8
        for (int i = 31; i >= 0; --i) {
            const int pos = 4 * i + sub;
            const f32x4 kv = *(const GAS f32x4*)(kp + (size_t)pos * 512), vv = *(const GAS f32x4*)(vp + (size_t)pos * 512);
            float z = (kv.x * qv.x + kv.y * qv.y) + (kv.z * qv.z + kv.w * qv.w);
            z += __shfl_xor(z, 1); z += __shfl_xor(z, 2); z += __shfl_xor(z, 4); z += __shfl_xor(z, 8);
            const float e = __builtin_amdgcn_exp2f(__builtin_fminf(z + biasl2, 100.0f)), r = __builtin_amdgcn_rcpf(1.0f + e), be = e * r;
            const float b1 = __shfl_xor(r, 16), c2 = r * b1, d2 = __shfl_xor(c2, 32);
            const float excl = ((sub & 1) ? 1.0f : b1) * ((sub < 2) ? d2 : 1.0f);
            const float wgt = be * excl * C; C *= c2 * d2;
            oacc = oacc + vv * wgt;
        }
    }
#pragma unroll
    for (int e = 0; e < 4; ++e) { float v = oacc[e]; v += __shfl_xor(v, 16); v += __shfl_xor(v, 32); oacc[e] = v; }
    float* P = WSP(float, WS_SBP) + (size_t)((b * 2 + half) * 8 + h) * 80;
    if (sub == 0) *(GAS f32x4*)(P + 4 * d4) = oacc;
    if (lane == 0) P[64] = C;
}
__device__ __forceinline__ void even_post_phase(Frame& F) {
    const float* P = WSP(const float, WS_SBP); bf16* O = WSP(bf16, WS_O);
    for (int i = blockIdx.x * (NWAVES * 64) + F.tid; i < NB_S * 512; i += F.G * NWAVES * 64) {
        const int b = i >> 9, c = i & 511, h = c >> 6, d = c & 63;
        const float* lo = P + (size_t)((b * 2 + 0) * 8 + h) * 80; const float* hi = P + (size_t)((b * 2 + 1) * 8 + h) * 80;
        O[(size_t)(MP + b) * 1024 + c] = (bf16)f2bf(hi[d] + hi[64] * lo[d]);
    }
}
__device__ __forceinline__ void pool_d_rows(Frame& F) {
#ifdef STUB_PD
    return;
#endif
    const int gw = blockIdx.x * NWAVES + F.wave, NGW = F.G * NWAVES, lane = F.lane;
    const float* U = WSP(const float, WS_U); bf16* D = WSP(bf16, WS_D); const float* sp = INP(I_SPOOL);
    for (int r = gw; r < MR; r += NGW) {
#pragma unroll
        for (int hf = 0; hf < 2; ++hf) {
            const int c = 256 * hf + 4 * lane, g = c >> 7, wdw = 2 << g;
            const f32x4 u0 = *(const GAS f32x4*)(U + (size_t)r * 512 + c);
            f32x4 s = u0; int cnt;
            if (r < MP) { const int t = r & (TSEQ - 1); cnt = (t + 1 < wdw) ? t + 1 : wdw;
                for (int j = 1; j < 16; ++j) if (j < cnt) s = s + *(const GAS f32x4*)(U + (size_t)(r - j) * 512 + c); }
            else { const int b = r - MP; cnt = wdw;
                for (int j = 1; j < 16; ++j) if (j < cnt) s = s + *(const GAS f32x4*)(sp + ((size_t)b * 15 + (15 - j)) * 512 + c); }
            const float inv = 1.0f / (float)cnt; const f32x4 dv = s * inv - u0;
            v2u o; o.x = pkbf(dv.x, dv.y); o.y = pkbf(dv.z, dv.w);
            *(GAS v2u*)(D + (size_t)r * 512 + c) = o;
        }
    }
}
__device__ __forceinline__ void pool_state_out(Frame& F) {
    const float* U = WSP(const float, WS_U); const float* sp = INP(I_SPOOL);
    const int gt = blockIdx.x * (NWAVES * 64) + F.tid, NT = F.G * NWAVES * 64;
    for (int i = gt; i < NB_P * 15 * 128; i += NT) { const int c4 = i & 127, j = (i >> 7) % 15, b = (i >> 7) / 15;
        *(GAS f32x4*)(F.out + O_POOLP + ((size_t)(b * 15 + j) * 512) + 4 * c4) = *(const GAS f32x4*)(U + ((size_t)b * TSEQ + TSEQ - 15 + j) * 512 + 4 * c4); }
    for (int i = gt; i < NB_S * 15 * 128; i += NT) { const int c4 = i & 127, j = (i >> 7) % 15, b = (i >> 7) / 15;
        const f32x4 v = (j < 14) ? *(const GAS f32x4*)(sp + ((size_t)b * 15 + j + 1) * 512 + 4 * c4) : *(const GAS f32x4*)(U + (size_t)(MP + b) * 512 + 4 * c4);
        *(GAS f32x4*)(F.out + O_POOLS + ((size_t)(b * 15 + j) * 512) + 4 * c4) = v; }
}
__device__ __forceinline__ void even_mix_phase(Frame& F) {
    for (int i = blockIdx.x; i < NB_S * 2; i += F.G) sb_sample_unit(F, i >> 1, i & 1);
    for (int i = blockIdx.x; i < 512; i += F.G) { const int bh = i & 63, qb = (i < 256) ? 7 - (i >> 6) : ((i - 256) >> 6); sb_prompt_unit(F, bh, qb); }
    pool_d_rows(F);
    pool_state_out(F);
}

constexpr int RK_PITCH = 528, RV_PITCH = 144;
constexpr int R_KL = 0, R_VL = R_KL + 128 * RK_PITCH, R_VD = R_VL + 128 * RV_PITCH, R_SL = R_VD + 128 * RV_PITCH, R_END = R_SL + 256 * RV_PITCH;
static_assert(R_END <= RING_BYTES, "retention LDS map");
__device__ __forceinline__ void ret_prompt_unit(Frame& F, int b, int h, int sl) {
#ifdef STUB_RP
    return;
#endif
    const int w = F.wave, lane = F.lane, tid = F.tid, r32 = lane & 31, hb = lane >> 5;
    const int q4 = (lane & 15) >> 2, p4 = lane & 3, blk = (lane >> 4) & 1;
    const int lt = (w < 4) ? ((0x2130 >> (4 * w)) & 15) : 3 - ((0x2130 >> (4 * (w - 4))) & 15), eh = w >> 2;
    const float gam = 1.0f - __builtin_amdgcn_exp2f(-5.0f - (float)h), lg = __builtin_log2f(gam);
    const size_t row0 = (size_t)b * TSEQ;
    const bf16* Rq = WSP(const bf16, WS_RQ) + row0 * 1024 + h * 256; const bf16* Rk = WSP(const bf16, WS_RK) + row0 * 1024 + h * 256;
    const bf16* Rv = WSP(const bf16, WS_RV) + row0 * 2048 + h * 512 + sl * 64; bf16* Ro = WSP(bf16, WS_RO) + row0 * 2048 + h * 512 + sl * 64;
    LAS unsigned char* KL = F.lds + RING_OFF + R_KL; LAS unsigned char* VL = F.lds + RING_OFF + R_VL; LAS unsigned char* VD = F.lds + RING_OFF + R_VD; LAS unsigned char* SL = F.lds + RING_OFF + R_SL;
    f32x16 sacc[2];
#pragma unroll
    for (int i = 0; i < 16; ++i) { sacc[0][i] = 0.f; sacc[1][i] = 0.f; }
    const float g128 = __builtin_amdgcn_exp2f(128.0f * lg);
    v4u kreg[8], vreg[2]; bf16x8 qf[16];
    const unsigned koff = (unsigned)((tid >> 5) * 1024 + (tid & 31) * 8) * 2u, voff = (unsigned)((tid >> 3) * 2048 + (tid & 7) * 8) * 2u, qoff = (unsigned)(r32 * 1024 + 8 * hb) * 2u;
#pragma unroll
    for (int i = 0; i < 8; ++i) kreg[i] = gld<v4u>(Rk + (size_t)(16 * i) * 1024, koff);
#pragma unroll
    for (int i = 0; i < 2; ++i) vreg[i] = gld<v4u>(Rv + (size_t)(64 * i) * 2048, voff);
#pragma unroll
    for (int s = 0; s < 16; ++s) qf[s] = gld<bf16x8>(Rq + (size_t)(32 * lt) * 1024 + 16 * s, qoff);
    for (int c = 0; c < 16; ++c) {
        WG_BAR();
        float lgc = lg; asm volatile("" : "+v"(lgc));
#pragma unroll
        for (int i = 0; i < 8; ++i) { const int p = tid + 512 * i; *(LAS v4u*)(KL + (p >> 5) * RK_PITCH + (p & 31) * 16) = kreg[i]; }
#pragma unroll
        for (int i = 0; i < 2; ++i) { const int p = tid + 512 * i, row = p >> 3; *(LAS v4u*)(VL + row * RV_PITCH + (p & 7) * 16) = vreg[i];
            const float f = __builtin_amdgcn_exp2f(lgc * (float)(127 - row)); v4u d;
            d.x = pkbf(bflo(vreg[i].x) * f, bfhi(vreg[i].x) * f); d.y = pkbf(bflo(vreg[i].y) * f, bfhi(vreg[i].y) * f); d.z = pkbf(bflo(vreg[i].z) * f, bfhi(vreg[i].z) * f); d.w = pkbf(bflo(vreg[i].w) * f, bfhi(vreg[i].w) * f);
            *(LAS v4u*)(VD + row * RV_PITCH + (p & 7) * 16) = d; }
#pragma unroll
        for (int e2 = 0; e2 < 2; ++e2)
#pragma unroll
            for (int g = 0; g < 4; ++g) { v2u o; o.x = pkbf(sacc[e2][4 * g], sacc[e2][4 * g + 1]); o.y = pkbf(sacc[e2][4 * g + 2], sacc[e2][4 * g + 3]);
                *(LAS v2u*)(SL + (32 * w + r32) * RV_PITCH + (32 * e2 + 8 * g + 4 * hb) * 2) = o; }
        WG_BAR();
        if (c < 15) {
            const bf16* nk = Rk + (size_t)(c + 1) * 128 * 1024; const bf16* nv = Rv + (size_t)(c + 1) * 128 * 2048;
#pragma unroll
            for (int i = 0; i < 8; ++i) kreg[i] = gld<v4u>(nk + (size_t)(16 * i) * 1024, koff);
#pragma unroll
            for (int i = 0; i < 2; ++i) vreg[i] = gld<v4u>(nv + (size_t)(64 * i) * 2048, voff);
        }
        f32x16 acc;
#pragma unroll
        for (int i = 0; i < 16; ++i) acc[i] = 0.f;
#pragma unroll
        for (int s = 0; s < 16; ++s) { const LAS unsigned char* a = SL + (16 * s + 8 * hb + q4) * RV_PITCH + (32 * eh + 16 * blk) * 2 + 8 * p4;
            acc = MFMA32(qf[s], tr_pair(a, a + 4 * RV_PITCH), acc); }
#pragma unroll
        for (int i = 0; i < 16; ++i) acc[i] *= __builtin_amdgcn_exp2f(lgc * (float)(32 * lt + crow(i, hb) + 1));
        for (int mt = 0; mt <= lt; ++mt) {
            f32x16 x;
#pragma unroll
            for (int i = 0; i < 16; ++i) x[i] = 0.f;
#pragma unroll
            for (int s = 0; s < 16; ++s) { const bf16x8 kf = *(const LAS bf16x8*)(KL + (32 * mt + r32) * RK_PITCH + (16 * s + 8 * hb) * 2); x = MFMA32(kf, qf[s], x); }
            float val[16];
#pragma unroll
            for (int i = 0; i < 16; ++i) { const int diff = (32 * lt + r32) - (32 * mt + crow(i, hb)); val[i] = (diff >= 0) ? x[i] * __builtin_amdgcn_exp2f(lgc * (float)diff) : 0.f; }
#pragma unroll
            for (int s2 = 0; s2 < 2; ++s2) { const bf16x8 xs = pack8(val[8 * s2], val[8 * s2 + 1], val[8 * s2 + 2], val[8 * s2 + 3], val[8 * s2 + 4], val[8 * s2 + 5], val[8 * s2 + 6], val[8 * s2 + 7]);
                const LAS unsigned char* a = VL + (32 * mt + 16 * s2 + 4 * hb + q4) * RV_PITCH + (32 * eh + 16 * blk) * 2 + 8 * p4;
                acc = MFMA32(xs, tr_pair(a, a + 8 * RV_PITCH), acc); }
        }
        { bf16* oub = Ro + (size_t)(c * 128 + 32 * lt) * 2048 + 32 * eh; const unsigned ooff = (unsigned)(4 * hb * 2048 + r32) * 2u;
#pragma unroll
          for (int i = 0; i < 16; ++i) gst<bf16>(oub + (size_t)crow(i, 0) * 2048, ooff, (bf16)f2bf(acc[i])); }
        if (c < 15) {
#pragma unroll
            for (int s = 0; s < 16; ++s) qf[s] = gld<bf16x8>(Rq + (size_t)((c + 1) * 128 + 32 * lt) * 1024 + 16 * s, qoff);
        }
#pragma unroll
        for (int i = 0; i < 16; ++i) { sacc[0][i] *= g128; sacc[1][i] *= g128; }
#pragma unroll
        for (int s = 0; s < 8; ++s) {
            const LAS unsigned char* kb = KL + (16 * s + 8 * hb + q4) * RK_PITCH + (32 * w + 16 * blk) * 2 + 8 * p4;
            const bf16x8 pb = tr_pair(kb, kb + 4 * RK_PITCH);
#pragma unroll
            for (int e2 = 0; e2 < 2; ++e2) { const LAS unsigned char* va = VD + (16 * s + 8 * hb + q4) * RV_PITCH + (32 * e2 + 16 * blk) * 2 + 8 * p4;
                sacc[e2] = MFMA32(tr_pair(va, va + 4 * RV_PITCH), pb, sacc[e2]); }
        }
    }
    float* So = F.out + O_RETP + ((size_t)(b * 4 + h) * 256 + 32 * w) * 512 + sl * 64; const unsigned sooff = (unsigned)(r32 * 512 + 4 * hb) * 4u;
#pragma unroll
    for (int e2 = 0; e2 < 2; ++e2)
#pragma unroll
        for (int g = 0; g < 4; ++g) gst<f32x4>(So + 32 * e2 + 8 * g, sooff, (f32x4){sacc[e2][4 * g], sacc[e2][4 * g + 1], sacc[e2][4 * g + 2], sacc[e2][4 * g + 3]});
}
__device__ __forceinline__ void ret_sample_unit(Frame& F, int b, int h) {
#ifdef STUB_RS
    return;
#endif
    const int tid = F.tid, e4 = tid & 127, dg = tid >> 7;
    const float gam = 1.0f - __builtin_amdgcn_exp2f(-5.0f - (float)h);
    const size_t row = (size_t)(MP + b);
    const bf16* Rq = WSP(const bf16, WS_RQ) + row * 1024 + h * 256; const bf16* Rk = WSP(const bf16, WS_RK) + row * 1024 + h * 256;
    const bf16* Rv = WSP(const bf16, WS_RV) + row * 2048 + h * 512; bf16* Ro = WSP(bf16, WS_RO) + row * 2048 + h * 512;
    LAS float* qs = (LAS float*)(F.lds + RING_OFF); LAS float* ks = qs + 256; LAS float* red = ks + 256;
    WG_BAR();
    if (tid < 256) { qs[tid] = bf2f(Rq[tid]); ks[tid] = bf2f(Rk[tid]); }
    const v2u vraw = *(const GAS v2u*)(Rv + 4 * e4); const f32x4 vv = {bflo(vraw.x), bfhi(vraw.x), bflo(vraw.y), bfhi(vraw.y)};
    WG_BAR();
    const float* S0 = INP(I_SRET) + ((size_t)(b * 4 + h) * 256) * 512 + 4 * e4; float* S1 = F.out + O_RETS + ((size_t)(b * 4 + h) * 256) * 512 + 4 * e4;
    f32x4 acc = {0.f, 0.f, 0.f, 0.f};
#pragma unroll 8
    for (int i = 0; i < 64; ++i) { const int d = 4 * i + dg; const f32x4 s = *(const GAS f32x4*)(S0 + (size_t)d * 512);
        acc = acc + s * qs[d]; *(GAS f32x4*)(S1 + (size_t)d * 512) = s * gam + vv * ks[d]; }
    *(LAS f32x4*)(red + dg * 512 + 4 * e4) = acc;
    if (tid < 64) { float s = 0.f;
#pragma unroll
        for (int j = 0; j < 4; ++j) s += qs[tid + 64 * j] * ks[tid + 64 * j];
        s = wave_sum(s); if (tid == 0) red[2048] = s; }
    WG_BAR();
    if (tid < 128) { const f32x4 cr = *(LAS f32x4*)(red + 4 * tid) + *(LAS f32x4*)(red + 512 + 4 * tid) + *(LAS f32x4*)(red + 1024 + 4 * tid) + *(LAS f32x4*)(red + 1536 + 4 * tid);
        const float qk = red[2048]; const f32x4 o = vv * qk + cr * gam;
        v2u w; w.x = pkbf(o.x, o.y); w.y = pkbf(o.z, o.w); *(GAS v2u*)(Ro + 4 * tid) = w; }
}
__device__ __forceinline__ void ret_mix_phase(Frame& F) {
    for (int i = blockIdx.x; i < 256; i += F.G) ret_prompt_unit(F, i >> 5, (i >> 3) & 3, i & 7);
    for (int i = blockIdx.x; i < NB_S * 4; i += F.G) ret_sample_unit(F, i >> 2, i & 3);
}
__device__ __forceinline__ void ret_norm_phase(Frame& F) {
#ifdef STUB_RN
    return;
#endif
    const int gw = blockIdx.x * NWAVES + F.wave, NGW = F.G * NWAVES, lane = F.lane;
    bf16* Ro = WSP(bf16, WS_RO); const bf16* Rg = WSP(const bf16, WS_RG);
    for (int r = gw; r < MR; r += NGW) {
#pragma unroll
        for (int hh = 0; hh < 4; ++hh) {
            const size_t off = (size_t)r * 2048 + hh * 512 + 8 * lane;
            const v4u xr = *(const GAS v4u*)(Ro + off), gr = *(const GAS v4u*)(Rg + off);
            float x[8] = {bflo(xr.x), bfhi(xr.x), bflo(xr.y), bfhi(xr.y), bflo(xr.z), bfhi(xr.z), bflo(xr.w), bfhi(xr.w)};
            const float g[8] = {bflo(gr.x), bfhi(gr.x), bflo(gr.y), bfhi(gr.y), bflo(gr.z), bfhi(gr.z), bflo(gr.w), bfhi(gr.w)};
            float s = 0.f;
#pragma unroll
            for (int e = 0; e < 8; ++e) s += x[e];
            const float mu = wave_sum(s) * (1.0f / 512.0f); float q = 0.f;
#pragma unroll
            for (int e = 0; e < 8; ++e) { x[e] -= mu; q += x[e] * x[e]; }
            const float rs = 1.0f / sqrtf(wave_sum(q) * (1.0f / 512.0f) + 1e-5f);
            v4u o; o.x = pkbf(x[0] * rs * g[0], x[1] * rs * g[1]); o.y = pkbf(x[2] * rs * g[2], x[3] * rs * g[3]); o.z = pkbf(x[4] * rs * g[4], x[5] * rs * g[5]); o.w = pkbf(x[6] * rs * g[6], x[7] * rs * g[7]);
            *(GAS v4u*)(Ro + off) = o;
        }
    }
}
constexpr int N_PHASES = 25;
__global__ void __launch_bounds__(NWAVES * 64, 2) fwd(Args args) {
    extern __shared__ __attribute__((aligned(16))) unsigned char lds[];
    Frame F;
    F.lds = (LAS unsigned char*)lds;
    F.MISC = (volatile LAS unsigned*)(F.lds + MISC_OFF);
    F.tid = threadIdx.x; F.lane = F.tid & 63; F.wave = __builtin_amdgcn_readfirstlane(F.tid >> 6);
    F.G = gridDim.x;
    F.ws = args.ws; F.out = args.out; F.ctl = (gu32*)(args.ws + WS_CTL);
    for (int u = F.tid; u < (LDS_BYTES - LDSCTL_OFF) / 4; u += NWAVES * 64) ((LAS unsigned*)(F.lds + LDSCTL_OFF))[u] = 0u;
    __syncthreads();
    const int lo = args.ph_lo, hi = args.ph_hi;
    const bool use_bar = (hi - lo) > 1;
    XcdBarrier bar; bar.bar = (unsigned*)(F.ctl + CW_BAR); bar.x = 0; bar.st = nullptr;
    if (use_bar) bar = xcd_barrier_post((unsigned*)(F.ctl + CW_BAR), F.MISC + 8);
    int p = 0;
#define PH_BEGIN if (p >= lo && p < hi) { asm volatile("" : "+s"(F.ws), "+s"(cu)); asm volatile("" : "+v"(F.tid)); F.lane = F.tid & 63; F.wave = __builtin_amdgcn_readfirstlane(F.tid >> 6);
#define PH_END } if (p >= lo && p + 1 < hi) xcd_barrier(bar); ++p;
    using namespace pg8;
    PG8_LAS unsigned char* ring = F.lds + RING_OFF;
    int cu = (int)blockIdx.x;

    PH_BEGIN p0_prologue(F); PH_END
    PH_BEGIN { Gemm g{WSP(bf16, WS_COND), WSP(bf16, WS_WADA), 256, 18432, 1024}; StaticOrder S; S.init(256, 18432, F.G, cu);
        EpiMod E{WSP(float, WS_MODT), INP(I_BADA), INP(I_NPRE), INP(I_NPOST), NB_TOT};
        gemm_phase<EpiMod, StaticOrder, true, true>(ring, g, S, E); } PH_END
    PH_BEGIN seam_phase(F, true, false, true, 0, 0); PH_END

#pragma unroll
    for (int l = 0; l < 2; ++l) {
#pragma unroll
        for (int s = 0; s < 3; ++s) {
            if (s != 1) {
                const int lf = l * 2 + (s >> 1);
                PH_BEGIN { Gemm g{WSP(bf16, WS_H), WSP(bf16, WS_WFIN + lf * WFIN_SZ), MPAD, 5632, 1024}; StaticOrder S; S.init(MPAD, 5632, F.G, cu);
                    EpiSwiGLU E{WSP(bf16, WS_G), DFF};
                    gemm_phase<EpiSwiGLU, StaticOrder, true, true>(ring, g, S, E); } PH_END
                PH_BEGIN { Gemm g{WSP(bf16, WS_G), WSP(bf16, WS_WFOUT + lf * WFOUT_SZ), MPAD, 1024, DFF}; StaticOrder S; S.init(MPAD, 1024, F.G, cu);
                    EpiF32 E{WSP(float, WS_Y), 1024};
                    gemm_phase<EpiF32, StaticOrder, true, true>(ring, g, S, E); } PH_END
            } else if (l == 0) {
                PH_BEGIN { Gemm g{WSP(bf16, WS_H), WSP(bf16, WS_WEI), MPAD, 2048, 1024}; StaticOrder S; S.init(MPAD, 2048, F.G, cu);
                    EpiEvenIn E{WSP(bf16, WS_Q), WSP(bf16, WS_KB), WSP(bf16, WS_VB), WSP(float, WS_U), F.out + O_KP, F.out + O_VP, F.out + O_KS, F.out + O_VS, 0.125f * LOG2E, MP, MR};
                    gemm_phase<EpiEvenIn, StaticOrder, true, true>(ring, g, S, E); } PH_END
                PH_BEGIN even_mix_phase(F); PH_END
                PH_BEGIN { even_post_phase(F);
                    Gemm g{WSP(bf16, WS_D), WSP(bf16, WS_WPOOL), MPAD, 512, 512}; StaticOrder S; S.init(MPAD, 512, F.G, cu);
                    EpiPool E{WSP(bf16, WS_O), INP(I_PS)};
                    gemm_phase<EpiPool, StaticOrder, true, true>(ring, g, S, E); } PH_END
                PH_BEGIN { Gemm g{WSP(bf16, WS_O), WSP(bf16, WS_WEO), MPAD, 1024, 1024}; StaticOrder S; S.init(MPAD, 1024, F.G, cu);
                    EpiF32 E{WSP(float, WS_Y), 1024};
                    gemm_phase<EpiF32, StaticOrder, true, true>(ring, g, S, E); } PH_END
            } else {
                PH_BEGIN { Gemm g{WSP(bf16, WS_H), WSP(bf16, WS_WOI), MPAD, 6144, 1024}; StaticOrder S; S.init(MPAD, 6144, F.G, cu);
                    EpiOddIn E{WSP(bf16, WS_RQ), WSP(bf16, WS_RK), WSP(bf16, WS_RV), WSP(bf16, WS_RG), MP};
                    gemm_phase<EpiOddIn, StaticOrder, true, true>(ring, g, S, E); } PH_END
                PH_BEGIN ret_mix_phase(F); PH_END
                PH_BEGIN ret_norm_phase(F); PH_END
                PH_BEGIN { Gemm g{WSP(bf16, WS_RO), WSP(bf16, WS_WOO), MPAD, 1024, 2048}; StaticOrder S; S.init(MPAD, 1024, F.G, cu);
                    EpiF32 E{WSP(float, WS_Y), 1024};
                    gemm_phase<EpiF32, StaticOrder, true, true>(ring, g, S, E); } PH_END
            }
            PH_BEGIN { const bool last = (l == 1 && s == 2); const int nl = (s == 2) ? l + 1 : l, ns = (s == 2) ? 0 : s + 1;
                seam_phase(F, l == 0 && s == 0, true, !last, l * 9216 + s * 3072, last ? 0 : nl * 9216 + ns * 3072); } PH_END
        }
    }
#undef PH_BEGIN
#undef PH_END
}

#ifndef MK_PER_PHASE
#define MK_PER_PHASE 0
#endif
extern "C" void kernel_launch(void* const* d_in, const int* in_sizes, int n_in, void* d_out, int out_size, void* d_ws, size_t ws_size, hipStream_t stream) {
    static int grid = 0;
    if (grid == 0) {
        if (n_in != N_IN || (size_t)out_size != O_END || ws_size < WS_END) { fprintf(stderr, "kernel_launch: unexpected shapes (n_in %d out %d ws %zu)\n", n_in, out_size, ws_size); grid = -1; return; }
        int dev = 0, cus = 0, per_cu = 0;
        if (hipGetDevice(&dev) != hipSuccess || hipDeviceGetAttribute(&cus, hipDeviceAttributeMultiprocessorCount, dev) != hipSuccess) { grid = -1; return; }
        if (hipFuncSetAttribute((const void*)fwd, hipFuncAttributeMaxDynamicSharedMemorySize, LDS_BYTES) != hipSuccess) { fprintf(stderr, "kernel_launch: hipFuncSetAttribute failed\n"); grid = -1; return; }
        if (hipOccupancyMaxActiveBlocksPerMultiprocessor(&per_cu, (const void*)fwd, NWAVES * 64, LDS_BYTES) != hipSuccess || per_cu < 1)
            fprintf(stderr, "kernel_launch: note: occupancy query reports %d workgroups per CU\n", per_cu);
        (void)hipGetLastError();
        grid = cus;
    }
    if (grid < 0) return;
    (void)hipMemsetAsync((char*)d_ws + WS_CTL, 0, CTL_ZERO_BYTES, stream);
    Args a{};
    for (int i = 0; i < N_IN; ++i) a.in[i] = (const float*)d_in[i];
    a.out = (float*)d_out; a.ws = (unsigned char*)d_ws;
#if MK_PER_PHASE
    for (int p = 0; p < N_PHASES; ++p) { a.ph_lo = p; a.ph_hi = p + 1; hipLaunchKernelGGL(fwd, dim3(grid), dim3(NWAVES * 64), LDS_BYTES, stream, a); }
#else
    a.ph_lo = 0; a.ph_hi = N_PHASES;
    hipLaunchKernelGGL(fwd, dim3(grid), dim3(NWAVES * 64), LDS_BYTES, stream, a);
#endif
    const hipError_t le = hipPeekAtLastError();
    if (le != hipSuccess) fprintf(stderr, "kernel_launch: launch failed: %s\n", hipGetErrorName(le));
}
```

```cpp
#include <hip/hip_runtime.h>
#include <cstdio>
#include <cstdint>
namespace pg8 {
#define PG8_LAS __attribute__((address_space(3)))
typedef unsigned short bf16_t;
typedef short bf16x8 __attribute__((ext_vector_type(8)));
typedef float f32x4 __attribute__((ext_vector_type(4)));
typedef unsigned u32x4 __attribute__((ext_vector_type(4)));
constexpr int BM = 256, BK = 64, HALF = 128, HTB = HALF * BK * 2  , STAGE_BYTES = 8 * HTB, NXCD = 8, WGM = 8;

__host__ __device__ __forceinline__ int lds_byte(int r, int c) { const int st = (r >> 4) * 2 + (c >> 5), rr = r & 15, cc = c & 31, ob = rr * 64 + cc * 2; return st * 1024 + (ob ^ (((ob >> 9) & 1) << 5)); }
__host__ __device__ __forceinline__ void stage_rc(int b, int& R, int& C) { const int st = b / 1024, sb = b % 1024, swz = sb ^ (((sb >> 9) & 1) << 5); R = (st >> 1) * 16 + swz / 64; C = (st & 1) * 32 + (swz % 64) / 2; }
__host__ __device__ __forceinline__ int perm32(int rho) { const int n = rho >> 4, i = rho & 15; return 8 * (i >> 2) + 4 * n + (i & 3); }

struct Unit { int pm, pn, kt0, nt; };
struct Gemm { const bf16_t* A; const bf16_t* Bt; int M, N, K; };

struct MixOrder {
    int nMp, nN, nP, nS, G, c, ntf, ks;
    __host__ __device__ void init(int nMp_, int N, int K, int ks_, int G_, int c_) { nMp = nMp_; nN = N / BM; nP = nMp * nN; ks = ks_; nS = nN * ks; G = G_; c = c_; ntf = K / BK; }
    __host__ __device__ bool next(int i, Unit& u) const {
        const long L = (long)i * G + c; if (L >= nP + nS) return false;
        int wgid = (int)L; { const int q = nP / NXCD, r = nP % NXCD, xcd = wgid % NXCD, off = wgid / NXCD; wgid = (xcd < r ? xcd * (q + 1) : r * (q + 1) + (xcd - r) * q) + off; }
        const int nig = WGM * nN, gid = wgid / nig, fm = gid * WGM, gsz = (nMp - fm) < WGM ? (nMp - fm) : WGM;
        const int ppm = fm + ((wgid % nig) % (gsz > 0 ? gsz : 1)), ppn = (wgid % nig) / (gsz > 0 ? gsz : 1);
        const bool smp = L >= nP; const int kss = ks > 0 ? ks : 1; const int j = (int)L - nP, spn = j / kss, snt = ntf / kss;
        u.pm = smp ? nMp : ppm; u.pn = smp ? spn : ppn; u.kt0 = smp ? (j - spn * kss) * snt : 0; u.nt = smp ? snt : ntf; return true;
    }
    __device__ __forceinline__ void a_ready(const Unit&) const {}
    __device__ __forceinline__ void done(const Unit&) const {}
};
__device__ __forceinline__ unsigned cvt_pk_bf16(float lo, float hi) { unsigned r; asm volatile("v_cvt_pk_bf16_f32 %0, %1, %2" : "=v"(r) : "v"(lo), "v"(hi)); return r; }
typedef unsigned u32x2 __attribute__((ext_vector_type(2)));
__device__ __forceinline__ float fast_rcp(float x) { return __builtin_amdgcn_rcpf(x); }
__device__ __forceinline__ float silu_f(float x) { return x * fast_rcp(1.0f + __builtin_amdgcn_exp2f(-1.4426950408889634f * x)); }

struct EpiMod {
    static constexpr bool PERM = false, AFTER_DRAIN = false;
    float* out; const float* b_ada; const float* norm_pre; const float* norm_post; int nrows;
    __device__ __forceinline__ void operator()(const f32x4 (&acc)[2][2][4][2], const Unit& u, int wr, int wc, int fr, int fq) const {
        const int ct = u.pn * BM; const int l = ct / 9216, cc0 = ct - l * 9216, sub = cc0 / 3072, j = (cc0 - sub * 3072) >> 10, d0 = cc0 & 1023;
        const float resw = (sub == 1) ? 1.0f : 0.5f;
#pragma unroll
        for (int bj = 0; bj < 2; ++bj)
#pragma unroll
            for (int n = 0; n < 2; ++n) {
                const int col = bj * HALF + wc * 32 + n * 16 + 4 * fq, gcol = ct + col, d = d0 + col;
                const f32x4 bias = *(const f32x4*)(b_ada + gcol);
                f32x4 gv = (f32x4){0.f, 0.f, 0.f, 0.f};
                if (j == 1) gv = *(const f32x4*)(norm_pre + (l * 3 + sub) * 1024 + d);
                if (j == 2) gv = *(const f32x4*)(norm_post + (l * 3 + sub) * 1024 + d) * resw;
#pragma unroll
                for (int ai = 0; ai < 2; ++ai)
#pragma unroll
                    for (int m = 0; m < 4; ++m) { const int row = ai * HALF + wr * 64 + m * 16 + fr;
                        f32x4 v = acc[ai][bj][m][n] + bias;
                        if (j == 1) v = gv * (v + 1.0f);
                        if (j == 2) v = gv * v;
                        if (row < nrows) *(f32x4*)(out + (size_t)row * 18432 + gcol) = v; }
            }
    }
};
struct EpiSwiGLU {
    static constexpr bool PERM = true, AFTER_DRAIN = false;
    bf16_t* G; int ldg;
    __device__ __forceinline__ void operator()(const f32x4 (&acc)[2][2][4][2], const Unit& u, int wr, int wc, int fr, int fq) const {
        const int col0 = u.pn * HALF + wc * 32 + 8 * fq;
#pragma unroll
        for (int ai = 0; ai < 2; ++ai)
#pragma unroll
            for (int m = 0; m < 4; ++m) { const int row = u.pm * BM + ai * HALF + wr * 64 + m * 16 + fr;
                float o[8];
#pragma unroll
                for (int n = 0; n < 2; ++n)
#pragma unroll
                    for (int e = 0; e < 4; ++e) o[n * 4 + e] = silu_f(acc[ai][0][m][n][e]) * acc[ai][1][m][n][e];
                u32x4 w; w.x = cvt_pk_bf16(o[0], o[1]); w.y = cvt_pk_bf16(o[2], o[3]); w.z = cvt_pk_bf16(o[4], o[5]); w.w = cvt_pk_bf16(o[6], o[7]);
                *(u32x4*)(G + (size_t)row * ldg + col0) = w; }
    }
};
struct EpiF32 {
    static constexpr bool PERM = false, AFTER_DRAIN = false;
    float* Y; int ldc; int ntf; float* Ys;
    __device__ __forceinline__ void operator()(const f32x4 (&acc)[2][2][4][2], const Unit& u, int wr, int wc, int fr, int fq) const {
        if (u.nt == ntf) {
#pragma unroll
            for (int ai = 0; ai < 2; ++ai)
#pragma unroll
                for (int m = 0; m < 4; ++m) { float* rowp = Y + (size_t)(u.pm * BM + ai * HALF + wr * 64 + m * 16 + fr) * ldc + u.pn * BM + wc * 32 + 4 * fq;
#pragma unroll
                    for (int bj = 0; bj < 2; ++bj)
#pragma unroll
                        for (int n = 0; n < 2; ++n) *(f32x4*)(rowp + bj * HALF + n * 16) = acc[ai][bj][m][n]; }
        } else {
            const int kq = u.kt0 / u.nt;
#pragma unroll
            for (int m = 0; m < 4; ++m) { float* rowp = Ys + ((size_t)kq * HALF + wr * 64 + m * 16 + fr) * ldc + u.pn * BM + wc * 32 + 4 * fq;
#pragma unroll
                for (int bj = 0; bj < 2; ++bj)
#pragma unroll
                    for (int n = 0; n < 2; ++n) *(f32x4*)(rowp + bj * HALF + n * 16) = acc[0][bj][m][n]; }
        }
    }
};
struct EpiEvenIn {
    static constexpr bool PERM = false, AFTER_DRAIN = false;
    bf16_t *Q, *Kb, *Vb; float* U; float *kp, *vp, *ks, *vs; float qscale; int mp, mtot;
    __device__ __forceinline__ void operator()(const f32x4 (&acc)[2][2][4][2], const Unit& u, int wr, int wc, int fr, int fq) const {
        const int t = u.pn >> 1, c0 = (u.pn & 1) * BM + wc * 32 + 4 * fq;
#pragma unroll
        for (int ai = 0; ai < 2; ++ai)
#pragma unroll
            for (int m = 0; m < 4; ++m) { const int row = u.pm * BM + ai * HALF + wr * 64 + m * 16 + fr;
#pragma unroll
                for (int bj = 0; bj < 2; ++bj)
#pragma unroll
                    for (int n = 0; n < 2; ++n) { const int c = c0 + bj * HALF + n * 16; const f32x4 v = acc[ai][bj][m][n];
                        if (t == 0) { const f32x4 s = v * qscale; u32x2 w; w.x = cvt_pk_bf16(s[0], s[1]); w.y = cvt_pk_bf16(s[2], s[3]); *(u32x2*)(Q + (size_t)row * 512 + c) = w; }
                        else if (t == 3) { *(f32x4*)(U + (size_t)row * 512 + c) = v; }
                        else { u32x2 w; w.x = cvt_pk_bf16(v[0], v[1]); w.y = cvt_pk_bf16(v[2], v[3]); *(u32x2*)((t == 1 ? Kb : Vb) + (size_t)row * 512 + c) = w;
                            if (row < mp) *(f32x4*)((t == 1 ? kp : vp) + (size_t)row * 512 + c) = v;
                            else if (row < mtot) *(f32x4*)((t == 1 ? ks : vs) + (size_t)(row - mp) * 512 + c) = v; } }
            }
    }
};
struct EpiOddIn {
    static constexpr bool PERM = true, AFTER_DRAIN = false;
    bf16_t *Rq, *Rk, *Rv, *Rg; int mp;
    __device__ __forceinline__ void operator()(const f32x4 (&acc)[2][2][4][2], const Unit& u, int wr, int wc, int fr, int fq) const {
        const int i0 = wc * 32 + 8 * fq;
        if (u.pn < 8) {
            bf16_t* dst = (u.pn < 4 ? Rq : Rk) + (u.pn & 3) * 256; const float osc = (u.pn < 4) ? 1.0f : 0.0625f;
            float invr[8];
#pragma unroll
            for (int q = 0; q < 8; ++q) invr[q] = __builtin_amdgcn_exp2f(-(float)(i0 + q) * (13.287712379549449f / 128.0f)) * 0.15915494309189535f;
#pragma unroll
            for (int ai = 0; ai < 2; ++ai)
#pragma unroll
                for (int m = 0; m < 4; ++m) { const int row = u.pm * BM + ai * HALF + wr * 64 + m * 16 + fr; const float pos = (row < mp) ? (float)(row & 2047) : 2048.0f;
                    float o1[8], o2[8];
#pragma unroll
                    for (int q = 0; q < 8; ++q) { float rev = pos * invr[q]; rev = rev - __builtin_rintf(rev);
                        const float sn = __builtin_amdgcn_sinf(rev), cs = __builtin_amdgcn_cosf(rev);
                        const float x1 = acc[ai][0][m][q >> 2][q & 3], x2 = acc[ai][1][m][q >> 2][q & 3];
                        o1[q] = (x1 * cs - x2 * sn) * osc; o2[q] = (x1 * sn + x2 * cs) * osc; }
                    u32x4 w1, w2; w1.x = cvt_pk_bf16(o1[0], o1[1]); w1.y = cvt_pk_bf16(o1[2], o1[3]); w1.z = cvt_pk_bf16(o1[4], o1[5]); w1.w = cvt_pk_bf16(o1[6], o1[7]);
                    w2.x = cvt_pk_bf16(o2[0], o2[1]); w2.y = cvt_pk_bf16(o2[2], o2[3]); w2.z = cvt_pk_bf16(o2[4], o2[5]); w2.w = cvt_pk_bf16(o2[6], o2[7]);
                    *(u32x4*)(dst + (size_t)row * 1024 + i0) = w1; *(u32x4*)(dst + (size_t)row * 1024 + 128 + i0) = w2; }
        } else {
            const bool isg = u.pn >= 16; bf16_t* dst = (isg ? Rg : Rv) + ((u.pn - 8) & 7) * 256;
#pragma unroll
            for (int ai = 0; ai < 2; ++ai)
#pragma unroll
                for (int m = 0; m < 4; ++m) { const int row = u.pm * BM + ai * HALF + wr * 64 + m * 16 + fr;
#pragma unroll
                    for (int bj = 0; bj < 2; ++bj) { float o[8];
#pragma unroll
                        for (int q = 0; q < 8; ++q) { const float x = acc[ai][bj][m][q >> 2][q & 3]; o[q] = isg ? silu_f(x) : x; }
                        u32x4 w; w.x = cvt_pk_bf16(o[0], o[1]); w.y = cvt_pk_bf16(o[2], o[3]); w.z = cvt_pk_bf16(o[4], o[5]); w.w = cvt_pk_bf16(o[6], o[7]);
                        *(u32x4*)(dst + (size_t)row * 2048 + bj * HALF + i0) = w; } }
        }
    }
};
struct EpiPool {
    static constexpr bool PERM = true, AFTER_DRAIN = false;
    bf16_t* O; const float* pscale;
    __device__ __forceinline__ void operator()(const f32x4 (&acc)[2][2][4][2], const Unit& u, int wr, int wc, int fr, int fq) const {
#pragma unroll
        for (int bj = 0; bj < 2; ++bj) { const int c0 = u.pn * BM + bj * HALF + wc * 32 + 8 * fq;
            const f32x4 s0 = *(const f32x4*)(pscale + c0), s1 = *(const f32x4*)(pscale + c0 + 4);
#pragma unroll
            for (int ai = 0; ai < 2; ++ai)
#pragma unroll
                for (int m = 0; m < 4; ++m) { const int row = u.pm * BM + ai * HALF + wr * 64 + m * 16 + fr;
                    const f32x4 a = acc[ai][bj][m][0] * s0, b = acc[ai][bj][m][1] * s1;
                    u32x4 w; w.x = cvt_pk_bf16(a[0], a[1]); w.y = cvt_pk_bf16(a[2], a[3]); w.z = cvt_pk_bf16(b[0], b[1]); w.w = cvt_pk_bf16(b[2], b[3]);
                    *(u32x4*)(O + (size_t)row * 1024 + 512 + c0) = w; } }
    }
};
template <class Epi, class Sched, bool ALIGN_EPI = false, bool SP2 = false>
__device__ __forceinline__ void gemm_phase(PG8_LAS unsigned char* lds, const Gemm g, const Sched& S, const Epi& E) {
    int tid_ = threadIdx.x; asm volatile("" : "+v"(tid_));
    const int tid = tid_, wid = __builtin_amdgcn_readfirstlane(tid >> 6), lane = tid & 63, wr = wid >> 2, wc = wid & 3, fr = lane & 15, fq = lane >> 4;
    const int K = g.K;
    unsigned voffA[2], voffB[2];
#pragma unroll
    for (int i = 0; i < 2; ++i) { int R, C; stage_rc(tid * 16 + i * 8192, R, C); const int Rb = Epi::PERM ? ((R & ~31) + perm32(R & 31)) : R;
        voffA[i] = (unsigned)(R * K + C) * 2u; voffB[i] = (unsigned)(Rb * K + C) * 2u; }
    const size_t kstep = (size_t)(BK * 2);
    const size_t hstep = (size_t)HALF * K * 2;
    const size_t tstep = 2 * hstep;
    const unsigned ldsw = (unsigned)wid * 1024u;
    const int aoff = lds_byte(wr * 64 + fr, fq * 8), boff = lds_byte(wc * 32 + fr, fq * 8);
#define PG8_SA(b, h) (((b) * 2 + (h)) * HTB)
#define PG8_SB(b, h) ((4 + (b) * 2 + (h)) * HTB)
#define PG8_STAGE(bufoff, gbase, voff) do { _Pragma("unroll") for (int _i = 0; _i < 2; ++_i) \
        __builtin_amdgcn_global_load_lds((const unsigned*)((const char*)(gbase) + (voff)[_i]), (PG8_LAS unsigned*)(lds + (bufoff) + ldsw + _i * 8192), 16, 0, 0); } while (0)
#define PG8_LDA(dst, b, h) do { _Pragma("unroll") for (int m = 0; m < 4; ++m) _Pragma("unroll") for (int k = 0; k < 2; ++k) dst[m][k] = *(const PG8_LAS bf16x8*)(lds + PG8_SA(b, h) + aoff + m * 2048 + k * 1024); } while (0)
#define PG8_LDB(dst, b, h) do { _Pragma("unroll") for (int n = 0; n < 2; ++n) _Pragma("unroll") for (int k = 0; k < 2; ++k) dst[n][k] = *(const PG8_LAS bf16x8*)(lds + PG8_SB(b, h) + boff + n * 2048 + k * 1024); } while (0)
#define PG8_MMA(ai, bj, At, Bt) do { __builtin_amdgcn_s_setprio(1); _Pragma("unroll") for (int m = 0; m < 4; ++m) _Pragma("unroll") for (int n = 0; n < 2; ++n) _Pragma("unroll") for (int k = 0; k < 2; ++k) \
        acc[ai][bj][m][n] = __builtin_amdgcn_mfma_f32_16x16x32_bf16(Bt[n][k], At[m][k], acc[ai][bj][m][n], 0, 0, 0); __builtin_amdgcn_s_setprio(0); } while (0)
#define PG8_WAIT_V(n) asm volatile("s_waitcnt vmcnt(" #n ")" ::: "memory")
#define PG8_WAIT_L(n) asm volatile("s_waitcnt lgkmcnt(" #n ")" ::: "memory")
#define PG8_BAR __builtin_amdgcn_s_barrier()
#define PG8_SCHED __builtin_amdgcn_sched_barrier(0)
    Unit cur, nxt; int ui = 0;
    if (!S.next(0, cur)) return;
    f32x4 acc[2][2][4][2];
#pragma unroll
    for (int a = 0; a < 2; ++a)
#pragma unroll
        for (int b = 0; b < 2; ++b)
#pragma unroll
            for (int m = 0; m < 4; ++m)
#pragma unroll
                for (int n = 0; n < 2; ++n) acc[a][b][m][n] = (f32x4){0.f, 0.f, 0.f, 0.f};
    bf16x8 At[4][2], B0[2][2], B1[2][2];
    const char* cA = (const char*)g.A + (size_t)cur.pm * tstep + (size_t)cur.kt0 * kstep; const char* cB = (const char*)g.Bt + (size_t)cur.pn * tstep + (size_t)cur.kt0 * kstep;
    S.a_ready(cur);
    if constexpr (SP2) {
        PG8_STAGE(PG8_SB(0, 0), cB, voffB); PG8_STAGE(PG8_SB(0, 1), cB + hstep, voffB); PG8_STAGE(PG8_SA(0, 0), cA, voffA); PG8_STAGE(PG8_SA(0, 1), cA + hstep, voffA);
        if (wr == 1) PG8_BAR;
        PG8_WAIT_V(2); PG8_BAR;
        PG8_STAGE(PG8_SB(1, 0), cB + kstep, voffB); PG8_STAGE(PG8_SA(1, 0), cA + kstep, voffA); PG8_STAGE(PG8_SB(1, 1), cB + hstep + kstep, voffB);
        PG8_WAIT_V(6); PG8_BAR;
    } else {
        PG8_STAGE(PG8_SB(0, 0), cB, voffB); PG8_STAGE(PG8_SA(0, 0), cA, voffA); PG8_STAGE(PG8_SB(0, 1), cB + hstep, voffB); PG8_STAGE(PG8_SA(0, 1), cA + hstep, voffA);
        if (wr == 1) PG8_BAR;
        PG8_WAIT_V(4); PG8_BAR;
        PG8_STAGE(PG8_SB(1, 0), cB + kstep, voffB); PG8_STAGE(PG8_SA(1, 0), cA + kstep, voffA); PG8_STAGE(PG8_SB(1, 1), cB + hstep + kstep, voffB);
        PG8_WAIT_V(6); PG8_BAR;
    }
    for (;;) {
        const bool has_next = S.next(ui + 1, nxt);
        const char* nA = has_next ? (const char*)g.A + (size_t)nxt.pm * tstep + (size_t)nxt.kt0 * kstep : cA; const char* nB = has_next ? (const char*)g.Bt + (size_t)nxt.pn * tstep + (size_t)nxt.kt0 * kstep : cB;
        const int nt = cur.nt;
        for (int t = 0; t < nt; t += 2) {
            const bool last = (t == nt - 2);
            const char* a1 = cA + (size_t)(t + 1) * kstep;
            const char* a2 = last ? nA : cA + (size_t)(t + 2) * kstep; const char* b2 = last ? nB : cB + (size_t)(t + 2) * kstep;
            const char* a3 = a2 + kstep; const char* b3 = b2 + kstep;
            if (last && has_next) S.a_ready(nxt);
            if constexpr (SP2) {
            PG8_LDB(B0, 0, 0); PG8_LDB(B1, 0, 1); PG8_SCHED; PG8_LDA(At, 0, 0); PG8_STAGE(PG8_SA(1, 1), a1 + hstep, voffA);
            PG8_WAIT_V(8); PG8_WAIT_L(0); PG8_BAR; PG8_MMA(0, 0, At, B0); PG8_MMA(0, 1, At, B1); PG8_BAR; PG8_SCHED;
            PG8_LDA(At, 0, 1); PG8_STAGE(PG8_SB(0, 0), b2, voffB); PG8_STAGE(PG8_SB(0, 1), b2 + hstep, voffB); PG8_STAGE(PG8_SA(0, 0), a2, voffA);
            PG8_WAIT_V(8); PG8_WAIT_L(0); PG8_BAR; PG8_MMA(1, 0, At, B0); PG8_MMA(1, 1, At, B1); PG8_BAR; PG8_SCHED;
            PG8_LDB(B0, 1, 0); PG8_LDB(B1, 1, 1); PG8_SCHED; PG8_LDA(At, 1, 0); PG8_STAGE(PG8_SA(0, 1), a2 + hstep, voffA);
            PG8_WAIT_V(8); PG8_WAIT_L(0); PG8_BAR; PG8_MMA(0, 0, At, B0); PG8_MMA(0, 1, At, B1); PG8_BAR; PG8_SCHED;
            PG8_LDA(At, 1, 1); PG8_STAGE(PG8_SB(1, 0), b3, voffB); PG8_STAGE(PG8_SB(1, 1), b3 + hstep, voffB); PG8_STAGE(PG8_SA(1, 0), a3, voffA);
            PG8_WAIT_V(8); PG8_WAIT_L(0); PG8_BAR; PG8_MMA(1, 0, At, B0); PG8_MMA(1, 1, At, B1); PG8_BAR; PG8_SCHED;
            } else {
            PG8_LDB(B0, 0, 0); PG8_SCHED; PG8_LDA(At, 0, 0); PG8_STAGE(PG8_SA(1, 1), a1 + hstep, voffA);
            PG8_WAIT_L(8); PG8_BAR; PG8_WAIT_L(0); PG8_MMA(0, 0, At, B0); PG8_BAR; PG8_SCHED;
            PG8_LDB(B1, 0, 1); PG8_STAGE(PG8_SB(0, 0), b2, voffB);
            PG8_BAR; PG8_WAIT_L(0); PG8_MMA(0, 1, At, B1); PG8_BAR;
            PG8_LDA(At, 0, 1); PG8_STAGE(PG8_SA(0, 0), a2, voffA);
            PG8_BAR; PG8_WAIT_L(0); PG8_MMA(1, 0, At, B0); PG8_BAR; PG8_SCHED;
            PG8_STAGE(PG8_SB(0, 1), b2 + hstep, voffB);
            PG8_WAIT_V(6); PG8_BAR; PG8_MMA(1, 1, At, B1); PG8_BAR;
            PG8_LDB(B0, 1, 0); PG8_SCHED; PG8_LDA(At, 1, 0); PG8_STAGE(PG8_SA(0, 1), a2 + hstep, voffA);
            PG8_WAIT_L(8); PG8_BAR; PG8_WAIT_L(0); PG8_MMA(0, 0, At, B0); PG8_BAR; PG8_SCHED;
            PG8_LDB(B1, 1, 1); PG8_STAGE(PG8_SB(1, 0), b3, voffB);
            PG8_BAR; PG8_WAIT_L(0); PG8_MMA(0, 1, At, B1); PG8_BAR;
            PG8_LDA(At, 1, 1); PG8_STAGE(PG8_SA(1, 0), a3, voffA);
            PG8_BAR; PG8_WAIT_L(0); PG8_MMA(1, 0, At, B0); PG8_BAR; PG8_SCHED;
            PG8_STAGE(PG8_SB(1, 1), b3 + hstep, voffB);
            PG8_WAIT_V(6); PG8_BAR; PG8_MMA(1, 1, At, B1); PG8_BAR;
            }
        }
        if constexpr (ALIGN_EPI) { if (wr == 0) PG8_BAR; }
        if constexpr (!Epi::AFTER_DRAIN) { E(acc, cur, wr, wc, fr, fq); S.done(cur); }
        if (!has_next) break;
#pragma unroll
        for (int a = 0; a < 2; ++a)
#pragma unroll
            for (int b = 0; b < 2; ++b)
#pragma unroll
                for (int m = 0; m < 4; ++m)
#pragma unroll
                    for (int n = 0; n < 2; ++n) acc[a][b][m][n] = (f32x4){0.f, 0.f, 0.f, 0.f};
        cur = nxt; cA = nA; cB = nB; ++ui;
        if constexpr (ALIGN_EPI) { if (wr == 1) PG8_BAR; }
    }
    PG8_WAIT_V(0);
    if constexpr (!ALIGN_EPI) { if (wr == 0) PG8_BAR; }
    PG8_BAR;
    if constexpr (Epi::AFTER_DRAIN) { E.fused(acc, cur, wr, wc, fr, fq, lds, wid, lane); S.done(cur); }
#undef PG8_SA
#undef PG8_SB
#undef PG8_STAGE
#undef PG8_LDA
#undef PG8_LDB
#undef PG8_MMA
#undef PG8_WAIT_V
#undef PG8_WAIT_L
#undef PG8_BAR
#undef PG8_SCHED
}
}
constexpr int NWAVES = 8;
constexpr int DM = 1024, NB_P = 8, TSEQ = 2048, NB_S = 128, NB_TOT = NB_P + NB_S;
constexpr int MP = NB_P * TSEQ;
constexpr int MR = MP + NB_S;
constexpr int MPAD = 16640;
constexpr int DFF = 2816, NPAGES = 16, PAGE = 128, NPHYS = 2560;
constexpr float NORM_EPS = 1e-6f;
constexpr float LOG2E = 1.4426950408889634f;
enum { I_XP = 0, I_XS, I_CP, I_CS, I_CK, I_CV, I_SPOOL, I_SRET, I_PT, I_WADA, I_BADA, I_NPRE, I_NPOST, I_FIN, I_FOUT, I_WIE, I_SBB, I_PW, I_PS, I_WOE, I_WIO, I_WOO, N_IN };
constexpr size_t O_Y = 0, O_KP = 16908288, O_VP = 25296896, O_POOLP = 33685504, O_RETP = 33746944, O_KS = 37941248, O_VS = 38006784, O_POOLS = 38072320, O_RETS = 39055360, O_END = 106164224;

constexpr size_t MiB = 1u << 20;
constexpr size_t al(size_t x) { return (x + 4095) & ~(size_t)4095; }
constexpr size_t WS_CTL = 0, CTL_ZERO_BYTES = 1 * MiB;
constexpr size_t WS_WADA = 2 * MiB;
constexpr size_t WS_WFIN = WS_WADA + al((size_t)18432 * 1024 * 2);
constexpr size_t WFIN_SZ = (size_t)5632 * 1024 * 2;
constexpr size_t WS_WFOUT = WS_WFIN + 4 * WFIN_SZ;
constexpr size_t WFOUT_SZ = (size_t)1024 * 2816 * 2;
constexpr size_t WS_WEI = WS_WFOUT + 4 * WFOUT_SZ;
constexpr size_t WS_WEO = WS_WEI + (size_t)2048 * 1024 * 2;
constexpr size_t WS_WPOOL = WS_WEO + (size_t)1024 * 1024 * 2;
constexpr size_t WS_WOI = WS_WPOOL + (size_t)512 * 512 * 2;
constexpr size_t WS_WOO = WS_WOI + (size_t)6144 * 1024 * 2;
constexpr size_t WS_COND = WS_WOO + (size_t)1024 * 2048 * 2;
constexpr size_t WS_MODT = WS_COND + (size_t)256 * 1024 * 2;
constexpr size_t WS_H = al(WS_MODT + (size_t)NB_TOT * 18432 * 4);
constexpr size_t WS_G = WS_H + (size_t)MPAD * 1024 * 2;
constexpr size_t WS_Y = WS_G + (size_t)MPAD * 2816 * 2;
constexpr size_t WS_Q = WS_Y + (size_t)MPAD * 1024 * 4;
constexpr size_t WS_KB = WS_Q + (size_t)MPAD * 512 * 2;
constexpr size_t WS_VB = WS_KB + (size_t)MPAD * 512 * 2;
constexpr size_t WS_U = WS_VB + (size_t)MPAD * 512 * 2;
constexpr size_t WS_D = WS_U + (size_t)MPAD * 512 * 4;
constexpr size_t WS_O = WS_D + (size_t)MPAD * 512 * 2;
constexpr size_t WS_RQ = WS_O + (size_t)MPAD * 1024 * 2;
constexpr size_t WS_RK = WS_RQ + (size_t)MPAD * 1024 * 2;
constexpr size_t WS_RV = WS_RK + (size_t)MPAD * 1024 * 2;
constexpr size_t WS_RG = WS_RV + (size_t)MPAD * 2048 * 2;
constexpr size_t WS_RO = WS_RG + (size_t)MPAD * 2048 * 2;
constexpr size_t WS_SBP = WS_RO + (size_t)MPAD * 2048 * 2;
constexpr size_t WS_YS = al(WS_SBP + (size_t)128 * 16 * 8 * 80 * 4);
constexpr size_t WS_END = al(WS_YS + (size_t)11 * 128 * 1024 * 4);
constexpr int CW_TMO = 0, CW_CODE = 1;
constexpr int CW_BAR = 4096;

constexpr int RING_OFF = 0, RING_BYTES = 155648;
constexpr int LDSCTL_OFF = RING_BYTES, MISC_OFF = LDSCTL_OFF + 320;
constexpr int LDS_BYTES = 156672;
static_assert(MISC_OFF + 128 <= LDS_BYTES, "LDS map");

#define GAS __attribute__((address_space(1)))
#define LAS __attribute__((address_space(3)))
typedef unsigned short bf16;
typedef unsigned v4u __attribute__((ext_vector_type(4)));
typedef unsigned v2u __attribute__((ext_vector_type(2)));
typedef float f32x4 __attribute__((ext_vector_type(4)));
typedef float f32x16 __attribute__((ext_vector_type(16)));
typedef short bf16x8 __attribute__((ext_vector_type(8)));
typedef short s16x4 __attribute__((ext_vector_type(4)));
typedef GAS unsigned gu32;
#define RLX_AGENT __ATOMIC_RELAXED, __HIP_MEMORY_SCOPE_AGENT
#define LDS_WAIT() asm volatile("s_waitcnt lgkmcnt(0)" ::: "memory")
#define VM_WAIT() asm volatile("s_waitcnt vmcnt(0)" ::: "memory")
__device__ __forceinline__ unsigned f2bf(float f) { unsigned u = __builtin_bit_cast(unsigned, f); return (u + 0x7fffu + ((u >> 16) & 1u)) >> 16; }
__device__ __forceinline__ unsigned pk2(float lo, float hi) { return f2bf(lo) | (f2bf(hi) << 16); }
__device__ __forceinline__ float bf2f(unsigned short h) { return __builtin_bit_cast(float, (unsigned)h << 16); }
__device__ __forceinline__ float bflo(unsigned w) { return __builtin_bit_cast(float, w << 16); }
__device__ __forceinline__ float bfhi(unsigned w) { return __builtin_bit_cast(float, w & 0xffff0000u); }
__device__ __forceinline__ float wave_sum(float v) {
#pragma unroll
    for (int o = 1; o < 64; o <<= 1) v += __shfl_xor(v, o);
    return v;
}
#define XB_TMO      128
#define XB_XCNT(j)  (256  + 64 * (j))
#define XB_XSUB(j)  (1280 + 64 * (j))
#define XB_XGEN(j)  (2304 + 64 * (j))
#define XB_TOP      3328
#define XB_TOPGEN   3392
#define XCD_BAR_WORDS 3456
#define XB_SPIN_CAP (1u << 18)

__device__ __forceinline__ unsigned xb_ld(unsigned* p)              { return __hip_atomic_load(p, __ATOMIC_RELAXED, __HIP_MEMORY_SCOPE_AGENT); }
__device__ __forceinline__ unsigned xb_add(unsigned* p, unsigned v) { return __hip_atomic_fetch_add(p, v, __ATOMIC_RELAXED, __HIP_MEMORY_SCOPE_AGENT); }
__device__ __forceinline__ unsigned xb_xcc_id() { return (unsigned)__builtin_amdgcn_s_getreg((3 << 11) | 20) & 0xFu; }
#define XB_SPIN(cond, bar) do { unsigned _sp = 0; while (cond) { __builtin_amdgcn_s_sleep(1); \
    if ((++_sp & 255u) == 0u) { if (xb_ld(&(bar)[XB_TMO])) break; if (_sp > XB_SPIN_CAP) { atomicAdd(&(bar)[XB_TMO], 1u); break; } } } } while (0)

struct XcdBarrier {
    unsigned* bar; unsigned x;
    volatile LAS unsigned* st;
};

__device__ __forceinline__ XcdBarrier xcd_barrier_post(unsigned* bar, volatile LAS unsigned* st) {
    XcdBarrier b; b.bar = bar; b.x = xb_xcc_id(); b.st = st;
    if (threadIdx.x == 0) (void)xb_add(&bar[XB_XCNT(b.x)], 1u);
    return b;
}
__device__ __forceinline__ void xcd_barrier_complete(unsigned* bar, unsigned x, unsigned& nloc, unsigned& nx) {
    const unsigned G = gridDim.x * gridDim.y * gridDim.z;
    unsigned sum, cnt, mine, sp = 0u;
    for (;;) {
        sum = 0u; cnt = 0u; mine = 0u;
#pragma unroll
        for (unsigned j = 0; j < 16; ++j) { const unsigned c = xb_ld(&bar[XB_XCNT(j)]); sum += c; cnt += (c > 0u) ? 1u : 0u; mine = (j == x) ? c : mine; }
        if (sum == G) break;
        __builtin_amdgcn_s_sleep(1);
        if ((++sp & 255u) == 0u) { if (xb_ld(&bar[XB_TMO])) break; if (sp > XB_SPIN_CAP) { atomicAdd(&bar[XB_TMO], 1u); break; } }
    }
    nloc = mine > 0u ? mine : 1u; nx = cnt > 0u ? cnt : 1u;
}

__device__ __forceinline__ void xcd_barrier(const XcdBarrier& b) {
    asm volatile("s_waitcnt vmcnt(0)" ::: "memory");
    __syncthreads();
    if (threadIdx.x == 0) {
        unsigned* bar = b.bar;
        __builtin_amdgcn_s_waitcnt(0);
        unsigned nloc = b.st[0], nx = b.st[1];
        if (nloc == 0u) { xcd_barrier_complete(bar, b.x, nloc, nx); b.st[0] = nloc; b.st[1] = nx; }
        const unsigned old = xb_add(&bar[XB_XSUB(b.x)], 1u);
        const unsigned gen = old / nloc;
        if (old + 1u == (gen + 1u) * nloc) {
            __builtin_amdgcn_fence(__ATOMIC_RELEASE, "agent");
            asm volatile("s_waitcnt vmcnt(0)" ::: "memory");
            const unsigned og = xb_add(&bar[XB_TOP], 1u);
            const unsigned tg = og / nx;
            if (og + 1u == (tg + 1u) * nx) xb_add(&bar[XB_TOPGEN], 1u);
            else XB_SPIN(xb_ld(&bar[XB_TOPGEN]) == tg, bar);
            __builtin_amdgcn_fence(__ATOMIC_ACQUIRE, "agent");
            xb_add(&bar[XB_XGEN(b.x)], 1u);
            asm volatile("s_waitcnt vmcnt(0)" ::: "memory");
        } else {
            XB_SPIN(xb_ld(&bar[XB_XGEN(b.x)]) == gen, bar);
            __builtin_amdgcn_fence(__ATOMIC_ACQUIRE, "agent");
            asm volatile("s_waitcnt vmcnt(0)" ::: "memory");
        }
    }
    __syncthreads();
}
struct Frame {
    LAS unsigned char* lds;
    volatile LAS unsigned* MISC;
    gu32* ctl;
    int tid, lane, wave;
    int G;
    float* out;
    unsigned char* ws;
};
struct Args { const float* in[N_IN]; float* out; unsigned char* ws; int ph_lo, ph_hi; };
#define KARG ((const __attribute__((address_space(4))) Args*)__builtin_amdgcn_kernarg_segment_ptr())
#define INP(i) (KARG->in[i])
#define WSP(T, off) ((T*)(F.ws + (off)))

__device__ __forceinline__ void tr_item(const float* Wblk, int ldw, bf16* WTblk, int ldwt, LAS float* scr, int lane, bool zero) {
    float v[32];
#pragma unroll
    for (int i = 0; i < 32; ++i) { const int kk = 2 * i + (lane >> 5); v[i] = zero ? 0.f : *(const GAS float*)(Wblk + (size_t)kk * ldw + (lane & 31)); }
#pragma unroll
    for (int i = 0; i < 32; ++i) { const int kk = 2 * i + (lane >> 5); scr[kk * 33 + (lane & 31)] = v[i]; }
    LDS_WAIT(); asm volatile("" ::: "memory");
    const int c = lane & 7;
#pragma unroll
    for (int j = 0; j < 4; ++j) { const int n = (lane >> 3) + 8 * j; const LAS float* s = scr + (8 * c) * 33 + n;
        v4u o; o.x = pk2(s[0 * 33], s[1 * 33]); o.y = pk2(s[2 * 33], s[3 * 33]); o.z = pk2(s[4 * 33], s[5 * 33]); o.w = pk2(s[6 * 33], s[7 * 33]);
        *(GAS v4u*)(WTblk + (size_t)n * ldwt + 8 * c) = o; }
    LDS_WAIT(); asm volatile("" ::: "memory");
}
__device__ __forceinline__ void tr_plain(const float* W, int K, int N, bf16* WT, LAS float* scr, int item, int lane) {
    const int nblk = N / 32, kb = item / nblk, nb = item - kb * nblk;
    tr_item(W + (size_t)(64 * kb) * N + 32 * nb, N, WT + (size_t)(32 * nb) * K + 64 * kb, K, scr, lane, false);
}
__device__ __forceinline__ void conv_ffn_item(Frame& F, int lf, int r, LAS float* scr) {
    constexpr int IT_FIN = 16 * 176;
    if (r < IT_FIN) {
        const int kb = r / 176, nb = r - kb * 176, n0 = 32 * nb; const int up = n0 >= DFF, j0 = up ? n0 - DFF : n0; const int row0 = 256 * (j0 >> 7) + 128 * up + (j0 & 127);
        tr_item(INP(I_FIN) + (size_t)lf * 1024 * 5632 + (size_t)(64 * kb) * 5632 + n0, 5632, WSP(bf16, WS_WFIN + lf * WFIN_SZ) + (size_t)row0 * 1024 + 64 * kb, 1024, scr, F.lane, false);
    } else tr_plain(INP(I_FOUT) + (size_t)lf * 2816 * 1024, 2816, 1024, WSP(bf16, WS_WFOUT + lf * WFOUT_SZ), scr, r - IT_FIN, F.lane);
}
__device__ __forceinline__ void conv_set(Frame& F, int set, int rank, int nw) {
    LAS float* scr = (LAS float*)(F.lds + RING_OFF + F.wave * 16384);
    constexpr int IT_ADA = 16 * 288, IT_FFN = 16 * 176 + 44 * 32, IT_EI = 16 * 64, IT_EO = 16 * 32, IT_OI = 16 * 192, IT_OO = 32 * 32, IT_PW = 8 * 16;
    if (set == 0) {
        constexpr int NITEMS = 2 * IT_ADA + IT_FFN + IT_EI + IT_EO + IT_PW;
        for (int it = rank; it < NITEMS; it += nw) {
            int r = it;
            if (r < 2 * IT_ADA) { const int l = r / IT_ADA; r -= l * IT_ADA; tr_plain(INP(I_WADA) + (size_t)l * 1024 * 9216, 1024, 9216, WSP(bf16, WS_WADA) + (size_t)l * 9216 * 1024, scr, r, F.lane); continue; } r -= 2 * IT_ADA;
            if (r < IT_FFN) { conv_ffn_item(F, 0, r, scr); continue; } r -= IT_FFN;
            if (r < IT_EI) { tr_plain(INP(I_WIE), 1024, 2048, WSP(bf16, WS_WEI), scr, r, F.lane); continue; } r -= IT_EI;
            if (r < IT_EO) { tr_plain(INP(I_WOE), 1024, 1024, WSP(bf16, WS_WEO), scr, r, F.lane); continue; } r -= IT_EO;
            {
                const int kb = r / 16, nb = r - kb * 16, k0 = 64 * kb, n0 = 32 * nb, gk = k0 >> 7, gn = n0 >> 7;
                tr_item(INP(I_PW) + (size_t)gk * 16384 + (size_t)(k0 & 127) * 128 + (n0 & 127), 128, WSP(bf16, WS_WPOOL) + (size_t)n0 * 512 + k0, 512, scr, F.lane, gk != gn); }
        }
        for (int row = rank; row < 256; row += nw) {
            const float* src = row < NB_P ? INP(I_CP) + (size_t)row * 1024 : INP(I_CS) + (size_t)(row - NB_P) * 1024;
            GAS unsigned long long* o8 = (GAS unsigned long long*)(WSP(bf16, WS_COND) + (size_t)row * 1024) + F.lane;
#pragma unroll
            for (int j = 0; j < 4; ++j) { f32x4 v = (f32x4){0.f, 0.f, 0.f, 0.f}; if (row < NB_TOT) v = *((const GAS f32x4*)src + F.lane + 64 * j);
                float s[4];
#pragma unroll
                for (int e = 0; e < 4; ++e) s[e] = v[e] / (1.0f + __expf(-v[e]));
                o8[64 * j] = (unsigned long long)pk2(s[0], s[1]) | ((unsigned long long)pk2(s[2], s[3]) << 32); }
        }
    } else if (set <= 3) {
        for (int it = rank; it < IT_FFN; it += nw) conv_ffn_item(F, set, it, scr);
    } else {
        for (int it = rank; it < IT_OI + IT_OO; it += nw) {
            if (it < IT_OI) tr_plain(INP(I_WIO), 1024, 6144, WSP(bf16, WS_WOI), scr, it, F.lane);
            else tr_plain(INP(I_WOO), 2048, 1024, WSP(bf16, WS_WOO), scr, it - IT_OI, F.lane);
        }
    }
}
__device__ __forceinline__ void conv_in_tail(Frame& F, int set, int total_units) {
    const int used = total_units % F.G, c = (int)blockIdx.x;
    if (used != 0 && c >= used) conv_set(F, set, (c - used) * NWAVES + F.wave, (F.G - used) * NWAVES);
}

__device__ __forceinline__ void seam_row(bool has_y, bool has_h, f32x4 (&x)[4], const f32x4 (&y)[4], const f32x4 (&gt)[4], const f32x4 (&sh)[4], const f32x4 (&sc)[4], float* Xrow, bf16* Hrow, int lane) {
    if (has_y) {
        float s = 0.f;
#pragma unroll
        for (int j = 0; j < 4; ++j) s += (y[j].x * y[j].x + y[j].y * y[j].y) + (y[j].z * y[j].z + y[j].w * y[j].w);
        const float rs = 1.0f / sqrtf(wave_sum(s) * (1.0f / 1024.0f) + NORM_EPS);
#pragma unroll
        for (int j = 0; j < 4; ++j) { x[j] = x[j] + gt[j] * y[j] * rs; *((GAS f32x4*)Xrow + lane + 64 * j) = x[j]; }
    }
    if (has_h) {
        float s = 0.f;
#pragma unroll
        for (int j = 0; j < 4; ++j) s += (x[j].x * x[j].x + x[j].y * x[j].y) + (x[j].z * x[j].z + x[j].w * x[j].w);
        const float rs = 1.0f / sqrtf(wave_sum(s) * (1.0f / 1024.0f) + NORM_EPS);
        GAS unsigned long long* o8 = (GAS unsigned long long*)Hrow + lane;
#pragma unroll
        for (int j = 0; j < 4; ++j) { const f32x4 h = x[j] * rs * sc[j] + sh[j];
            o8[64 * j] = (unsigned long long)pk2(h.x, h.y) | ((unsigned long long)pk2(h.z, h.w) << 32); }
    }
}
__device__ __forceinline__ void seam_phase(Frame& F, bool first, bool has_y, bool has_h, int gate_off, int pre_off, int ks) {
    const int gw = blockIdx.x * NWAVES + F.wave, NGW = F.G * NWAVES, lane = F.lane;
    const float* MT = WSP(const float, WS_MODT); const float* Y = WSP(const float, WS_Y); bf16* H = WSP(bf16, WS_H); float* X = F.out + O_Y;
    f32x4 gt[4], sh[4], sc[4], x[4], y[4], xn[4], yn[4];
#pragma unroll
    for (int j = 0; j < 4; ++j) { gt[j] = (f32x4){0.f, 0.f, 0.f, 0.f}; sh[j] = gt[j]; sc[j] = gt[j]; y[j] = gt[j]; yn[j] = gt[j]; }
    { const int per = (MP + NGW - 1) / NGW, r0 = gw * per, r1 = (r0 + per < MP) ? r0 + per : MP;
      const float* xsrc = first ? INP(I_XP) : X;
      int bcur = -1;
      if (r0 < r1) {
#pragma unroll
          for (int j = 0; j < 4; ++j) { x[j] = *((const GAS f32x4*)(xsrc + (size_t)r0 * 1024) + lane + 64 * j); if (has_y) y[j] = *((const GAS f32x4*)(Y + (size_t)r0 * 1024) + lane + 64 * j); } }
      for (int r = r0; r < r1; ++r) {
          const int b = r >> 11;
          if (b != bcur) { bcur = b; const float* T = MT + (size_t)b * 18432;
#pragma unroll
              for (int j = 0; j < 4; ++j) { if (has_y) gt[j] = *((const GAS f32x4*)(T + gate_off + 2048) + lane + 64 * j);
                  if (has_h) { sh[j] = *((const GAS f32x4*)(T + pre_off) + lane + 64 * j); sc[j] = *((const GAS f32x4*)(T + pre_off + 1024) + lane + 64 * j); } } }
          if (r + 1 < r1) {
#pragma unroll
              for (int j = 0; j < 4; ++j) { xn[j] = *((const GAS f32x4*)(xsrc + (size_t)(r + 1) * 1024) + lane + 64 * j); if (has_y) yn[j] = *((const GAS f32x4*)(Y + (size_t)(r + 1) * 1024) + lane + 64 * j); } }
          seam_row(has_y, has_h, x, y, gt, sh, sc, X + (size_t)r * 1024, H + (size_t)r * 1024, lane);
#pragma unroll
          for (int j = 0; j < 4; ++j) { x[j] = xn[j]; y[j] = yn[j]; }
      } }
    for (int rs_ = NGW - 1 - gw; rs_ < NB_S; rs_ += NGW) {
        const int r = MP + rs_; const float* T = MT + (size_t)(NB_P + rs_) * 18432;
        const float* xrow = first ? INP(I_XS) + (size_t)rs_ * 1024 : X + (size_t)r * 1024; const float* ys = WSP(const float, WS_YS) + (size_t)rs_ * 1024;
#pragma unroll
        for (int j = 0; j < 4; ++j) { x[j] = *((const GAS f32x4*)xrow + lane + 64 * j);
            if (has_y) { y[j] = *((const GAS f32x4*)ys + lane + 64 * j); gt[j] = *((const GAS f32x4*)(T + gate_off + 2048) + lane + 64 * j); }
            if (has_h) { sh[j] = *((const GAS f32x4*)(T + pre_off) + lane + 64 * j); sc[j] = *((const GAS f32x4*)(T + pre_off + 1024) + lane + 64 * j); } }
        if (has_y) for (int q = 1; q < ks; ++q)
#pragma unroll
            for (int j = 0; j < 4; ++j) y[j] = y[j] + *((const GAS f32x4*)(ys + (size_t)q * NB_S * 1024) + lane + 64 * j);
        seam_row(has_y, has_h, x, y, gt, sh, sc, X + (size_t)r * 1024, H + (size_t)r * 1024, lane);
    }
}
#define MFMA32(a, b, c) __builtin_amdgcn_mfma_f32_32x32x16_bf16((a), (b), (c), 0, 0, 0)
typedef float f32x2 __attribute__((ext_vector_type(2)));
typedef __bf16 bf16v2 __attribute__((ext_vector_type(2)));
__device__ __forceinline__ unsigned pkbf(float a, float b) { f32x2 v = {a, b}; bf16v2 r = __builtin_convertvector(v, bf16v2); return __builtin_bit_cast(unsigned, r); }
__device__ __forceinline__ bf16x8 pack8(float a0, float a1, float a2, float a3, float a4, float a5, float a6, float a7) {
    v4u p; p.x = pkbf(a0, a1); p.y = pkbf(a2, a3); p.z = pkbf(a4, a5); p.w = pkbf(a6, a7); return __builtin_bit_cast(bf16x8, p); }
__device__ __forceinline__ int crow(int i, int hb) { return (i & 3) + 8 * (i >> 2) + 4 * hb; }
__device__ __forceinline__ s16x4 tr_read(const LAS unsigned char* p) { return __builtin_amdgcn_ds_read_tr16_b64_v4i16((LAS s16x4*)p); }
__device__ __forceinline__ bf16x8 tr_pair(const LAS unsigned char* lo, const LAS unsigned char* hi) { const s16x4 a = tr_read(lo), b = tr_read(hi); return __builtin_shufflevector(a, b, 0, 1, 2, 3, 4, 5, 6, 7); }
__device__ __forceinline__ float partner32(float x, int hb) {
    const unsigned u = __builtin_bit_cast(unsigned, x);
    auto r = __builtin_amdgcn_permlane32_swap(u, u, false, false);
    return __builtin_bit_cast(float, hb ? r[0] : r[1]);
}
template <class T> __device__ __forceinline__ T gld(const void* ubase, unsigned voff) { return *(const GAS T*)((const GAS char*)ubase + voff); }
template <class T> __device__ __forceinline__ void gst(void* ubase, unsigned voff, T v) { *(GAS T*)((GAS char*)ubase + voff) = v; }
#define WG_BAR() do { asm volatile("s_waitcnt lgkmcnt(0)" ::: "memory"); __builtin_amdgcn_s_barrier(); asm volatile("" ::: "memory"); } while (0)

constexpr int SB_PITCH = 144;
constexpr int SB_TILE = 64 * SB_PITCH;
template <bool DIAG>
__device__ __forceinline__ void sb_subtile(const LAS unsigned char* Kt, const LAS unsigned char* Vt, int sub, const bf16x8 (&qf)[4], float biasl2, float& C, f32x16 (&o)[2], int lane) {
    const int r32 = lane & 31, hb = lane >> 5;
    f32x16 acc;
#pragma unroll
    for (int i = 0; i < 16; ++i) acc[i] = biasl2;
#pragma unroll
    for (int c = 0; c < 4; ++c) { const bf16x8 kf = *(const LAS bf16x8*)(Kt + (32 * sub + r32) * SB_PITCH + 32 * c + 16 * hb); acc = MFMA32(kf, qf[c], acc); }
    float r[16], be[16];
#pragma unroll
    for (int i = 0; i < 16; ++i) { const float e = __builtin_amdgcn_exp2f(__builtin_fminf(acc[i], 100.0f)); r[i] = __builtin_amdgcn_rcpf(1.0f + e); be[i] = e * r[i];
        if (DIAG) { if (crow(i, hb) >= r32) { r[i] = 1.0f; be[i] = 0.0f; } } }
    float sfx[16], T[4], Tp[4];
#pragma unroll
    for (int g = 0; g < 4; ++g) { const float a0 = r[4 * g], a1 = r[4 * g + 1], a2 = r[4 * g + 2], a3 = r[4 * g + 3];
        sfx[4 * g + 3] = 1.0f; sfx[4 * g + 2] = a3; const float s1 = a2 * a3; sfx[4 * g + 1] = s1; const float s0 = a1 * s1; sfx[4 * g] = s0; T[g] = a0 * s0; Tp[g] = partner32(T[g], hb); }
    const float p3 = T[3] * Tp[3], p2 = T[2] * Tp[2], p1 = T[1] * Tp[1], p0 = T[0] * Tp[0];
    float suf[4]; suf[3] = 1.0f; suf[2] = p3; suf[1] = p2 * p3; suf[0] = p1 * suf[1]; const float tot = p0 * suf[0];
    float w[16];
#pragma unroll
    for (int g = 0; g < 4; ++g) { const float off = C * suf[g] * (hb == 0 ? Tp[g] : 1.0f);
#pragma unroll
        for (int e = 0; e < 4; ++e) w[4 * g + e] = be[4 * g + e] * sfx[4 * g + e] * off; }
    C *= tot;
    const int q4 = (lane & 15) >> 2, p4 = lane & 3, blk = (lane >> 4) & 1;
#pragma unroll
    for (int s = 0; s < 2; ++s) { const bf16x8 xs = pack8(w[8 * s], w[8 * s + 1], w[8 * s + 2], w[8 * s + 3], w[8 * s + 4], w[8 * s + 5], w[8 * s + 6], w[8 * s + 7]);
#pragma unroll
        for (int dh = 0; dh < 2; ++dh) { const LAS unsigned char* a = Vt + (32 * sub + 16 * s + 4 * hb + q4) * SB_PITCH + (32 * dh + 16 * blk) * 2 + 8 * p4;
            const bf16x8 pb = tr_pair(a, a + 8 * SB_PITCH); o[dh] = MFMA32(xs, pb, o[dh]); } }
}
constexpr int SBW_BUF = 2 * 32 * SB_PITCH;
constexpr int SBW_WAVE = 2 * SBW_BUF;
static_assert(8 * SBW_WAVE <= RING_BYTES, "attention LDS map");
__device__ __forceinline__ void sb_prompt_item(Frame& F, int bh, int qt) {
#ifdef STUB_SBP
    return;
#endif
    const int b = bh >> 3, h = bh & 7, lane = F.lane, r32 = lane & 31, hb = lane >> 5;
    const bf16* Q = WSP(const bf16, WS_Q); const bf16* Kb = WSP(const bf16, WS_KB); const bf16* Vb = WSP(const bf16, WS_VB); bf16* O = WSP(bf16, WS_O);
    const size_t rowb = (size_t)b * TSEQ;
    bf16x8 qf[4];
    { const bf16* qub = Q + (rowb + 32 * qt) * 512 + h * 64; const unsigned qoff = (unsigned)(r32 * 512 + 8 * hb) * 2u;
#pragma unroll
      for (int c = 0; c < 4; ++c) qf[c] = gld<bf16x8>(qub + 16 * c, qoff); }
    const float biasl2 = INP(I_SBB)[h] * LOG2E;
    f32x16 o[2];
#pragma unroll
    for (int i = 0; i < 16; ++i) { o[0][i] = 0.f; o[1][i] = 0.f; }
    float C = 1.0f;
    const int kr = lane >> 3, pc = lane & 7;
    const bf16* kub = Kb + rowb * 512 + h * 64; const bf16* vub = Vb + rowb * 512 + h * 64; const unsigned kvoff = (unsigned)(kr * 512 + pc * 8) * 2u;
    v4u kreg[4], vreg[4];
#pragma unroll
    for (int i = 0; i < 4; ++i) { kreg[i] = gld<v4u>(kub + (size_t)(32 * qt + 8 * i) * 512, kvoff); vreg[i] = gld<v4u>(vub + (size_t)(32 * qt + 8 * i) * 512, kvoff); }
    LAS unsigned char* wb = F.lds + RING_OFF + F.wave * SBW_WAVE;
    for (int s = qt; s >= 0; --s) {
        LAS unsigned char* Kt = wb + (s & 1) * SBW_BUF; LAS unsigned char* Vt = Kt + 32 * SB_PITCH;
#pragma unroll
        for (int i = 0; i < 4; ++i) { *(LAS v4u*)(Kt + (8 * i + kr) * SB_PITCH + pc * 16) = kreg[i]; *(LAS v4u*)(Vt + (8 * i + kr) * SB_PITCH + pc * 16) = vreg[i]; }
        if (s > 0) {
#pragma unroll
            for (int i = 0; i < 4; ++i) { kreg[i] = gld<v4u>(kub + (size_t)(32 * (s - 1) + 8 * i) * 512, kvoff); vreg[i] = gld<v4u>(vub + (size_t)(32 * (s - 1) + 8 * i) * 512, kvoff); } }
        if (s == qt) sb_subtile<true>(Kt, Vt, 0, qf, biasl2, C, o, lane); else sb_subtile<false>(Kt, Vt, 0, qf, biasl2, C, o, lane);
    }
    bf16* oub = O + (rowb + 32 * qt) * 1024 + h * 64; const unsigned ooff = (unsigned)(4 * hb * 1024 + r32) * 2u;
#pragma unroll
    for (int dh = 0; dh < 2; ++dh)
#pragma unroll
        for (int i = 0; i < 16; ++i) gst<bf16>(oub + (size_t)crow(i, 0) * 1024 + 32 * dh, ooff, (bf16)f2bf(o[dh][i]));
}

template <int CTRL> __device__ __forceinline__ float dpp_f(float x) { return __builtin_bit_cast(float, __builtin_amdgcn_update_dpp(0, __builtin_bit_cast(int, x), CTRL, 0xf, 0xf, true)); }
__device__ __forceinline__ float row16_sum(float x) {
    x += dpp_f<0xB1>(x); x += dpp_f<0x4E>(x); x += dpp_f<0x141>(x); x += dpp_f<0x140>(x); return x; }
constexpr int SBS_STRIDE = 80;
__device__ __forceinline__ void sb_sample_item(Frame& F, int b, int pg) {
#ifdef STUB_SBS
    return;
#endif
    const int lane = F.lane, d4 = lane & 15, hl = lane >> 4;
    const float* ck = INP(I_CK); const float* cv = INP(I_CV); const int* pt = (const int*)INP(I_PT);
    const bf16* Q = WSP(const bf16, WS_Q);
    f32x4 qv[2]; float bias2[2];
#pragma unroll
    for (int hh = 0; hh < 2; ++hh) { const v2u qraw = *(const GAS v2u*)(Q + (size_t)(MP + b) * 512 + hh * 256 + 4 * lane);
        qv[hh] = (f32x4){bflo(qraw.x), bfhi(qraw.x), bflo(qraw.y), bfhi(qraw.y)}; bias2[hh] = INP(I_SBB)[4 * hh + hl] * LOG2E; }
    f32x4 oacc[2] = {(f32x4){0.f, 0.f, 0.f, 0.f}, (f32x4){0.f, 0.f, 0.f, 0.f}}; float C[2] = {1.0f, 1.0f};
    const int phys = __builtin_amdgcn_readfirstlane(pt[b * NPAGES + pg]);
    const float* kp = ck + (size_t)phys * (PAGE * 512); const float* vp = cv + (size_t)phys * (PAGE * 512);
    const unsigned loff = (unsigned)lane * 16u;
    f32x4 ka[8], va[8], kb[8], vb[8];
#define SBS_LOAD(KK, VV, t) do { _Pragma("unroll") for (int u = 0; u < 4; ++u) { const int pos_ = 127 - 4 * (t) - u; _Pragma("unroll") for (int hh = 0; hh < 2; ++hh) { \
        KK[2 * u + hh] = __builtin_nontemporal_load((const GAS f32x4*)((const GAS char*)(kp + (size_t)pos_ * 512 + hh * 256) + loff)); \
        VV[2 * u + hh] = __builtin_nontemporal_load((const GAS f32x4*)((const GAS char*)(vp + (size_t)pos_ * 512 + hh * 256) + loff)); } } } while (0)
#define SBS_COMP(KK, VV) do { _Pragma("unroll") for (int u = 0; u < 4; ++u) _Pragma("unroll") for (int hh = 0; hh < 2; ++hh) { const f32x4 kv = KK[2 * u + hh]; \
        float z = (kv.x * qv[hh].x + kv.y * qv[hh].y) + (kv.z * qv[hh].z + kv.w * qv[hh].w); z = row16_sum(z); \
        const float e = __builtin_amdgcn_exp2f(__builtin_fminf(z + bias2[hh], 100.0f)), r = __builtin_amdgcn_rcpf(1.0f + e); \
        const float wgt = e * r * C[hh]; C[hh] *= r; oacc[hh] = oacc[hh] + VV[2 * u + hh] * wgt; } } while (0)
    SBS_LOAD(ka, va, 0);
    for (int t = 0; t < 32; t += 2) {
        SBS_LOAD(kb, vb, t + 1);
        SBS_COMP(ka, va);
        if (t + 2 < 32) SBS_LOAD(ka, va, t + 2);
        SBS_COMP(kb, vb);
    }
#undef SBS_LOAD
#undef SBS_COMP
    float* P = WSP(float, WS_SBP) + (size_t)((b * NPAGES + pg) * 8) * SBS_STRIDE;
#pragma unroll
    for (int hh = 0; hh < 2; ++hh) { float* Ph = P + (4 * hh + hl) * SBS_STRIDE; *(GAS f32x4*)(Ph + 4 * d4) = oacc[hh]; if (d4 == 0) Ph[64] = C[hh]; }
}
__device__ __forceinline__ void even_post_phase(Frame& F) {
    const float* P = WSP(const float, WS_SBP); bf16* O = WSP(bf16, WS_O);
    for (int i = blockIdx.x * (NWAVES * 64) + F.tid; i < NB_S * 512; i += F.G * NWAVES * 64) {
        const int b = i >> 9, c = i & 511, h = c >> 6, d = c & 63;
        float acc = 0.f, carry = 1.0f;
        for (int pg = NPAGES - 1; pg >= 0; --pg) { const float* rec = P + (size_t)((b * NPAGES + pg) * 8 + h) * SBS_STRIDE; acc += carry * rec[d]; carry *= rec[64]; }
        O[(size_t)(MP + b) * 1024 + c] = (bf16)f2bf(acc);
    }
}
__device__ __forceinline__ void pool_d_rows(Frame& F) {
    const int gw = blockIdx.x * NWAVES + F.wave, NGW = F.G * NWAVES, lane = F.lane;
    const float* U = WSP(const float, WS_U); bf16* D = WSP(bf16, WS_D); const float* sp = INP(I_SPOOL);
    for (int ch = gw; ch < MP / 8; ch += NGW) {
        const int r0 = ch * 8, rb = r0 & ~(TSEQ - 1), t0 = r0 - rb;
        f32x4 A[11], Bq[23];
#pragma unroll
        for (int k = 0; k < 11; ++k) { int rr = r0 - 3 + k; rr = rr < rb ? rb : rr; A[k] = *(const GAS f32x4*)(U + (size_t)rr * 512 + 4 * lane); }
#pragma unroll
        for (int k = 0; k < 23; ++k) { int rr = r0 - 15 + k; rr = rr < rb ? rb : rr; Bq[k] = *(const GAS f32x4*)(U + (size_t)rr * 512 + 256 + 4 * lane); }
        const int w0 = 2 << (lane >> 5), w1 = 8 << (lane >> 5);
#pragma unroll
        for (int i = 0; i < 8; ++i) { const int t = t0 + i; const int c0 = (t + 1 < w0) ? t + 1 : w0, c1 = (t + 1 < w1) ? t + 1 : w1;
            f32x4 s0 = A[3 + i], s1 = Bq[15 + i];
#pragma unroll
            for (int j = 1; j < 4; ++j) { const f32x4 v = A[3 + i - j]; if (j < c0) s0 = s0 + v; }
#pragma unroll
            for (int j = 1; j < 16; ++j) { const f32x4 v = Bq[15 + i - j]; if (j < c1) s1 = s1 + v; }
            const f32x4 d0 = s0 * (1.0f / (float)c0) - A[3 + i], d1 = s1 * (1.0f / (float)c1) - Bq[15 + i];
            v2u o0, o1; o0.x = pkbf(d0.x, d0.y); o0.y = pkbf(d0.z, d0.w); o1.x = pkbf(d1.x, d1.y); o1.y = pkbf(d1.z, d1.w);
            *(GAS v2u*)(D + (size_t)(r0 + i) * 512 + 4 * lane) = o0; *(GAS v2u*)(D + (size_t)(r0 + i) * 512 + 256 + 4 * lane) = o1; }
    }
    for (int rs_ = NGW - 1 - gw; rs_ < NB_S; rs_ += NGW) {
        const int r = MP + rs_;
#pragma unroll
        for (int hf = 0; hf < 2; ++hf) {
            const int c = 256 * hf + 4 * lane, g = c >> 7, wdw = 2 << g;
            const f32x4 u0 = *(const GAS f32x4*)(U + (size_t)r * 512 + c);
            f32x4 s = u0;
            for (int j = 1; j < 16; ++j) if (j < wdw) s = s + *(const GAS f32x4*)(sp + ((size_t)rs_ * 15 + (15 - j)) * 512 + c);
            const f32x4 dv = s * (1.0f / (float)wdw) - u0;
            v2u o; o.x = pkbf(dv.x, dv.y); o.y = pkbf(dv.z, dv.w);
            *(GAS v2u*)(D + (size_t)r * 512 + c) = o;
        }
    }
}
__device__ __forceinline__ void pool_state_out(Frame& F) {
    const float* U = WSP(const float, WS_U); const float* sp = INP(I_SPOOL);
    const int gt = blockIdx.x * (NWAVES * 64) + F.tid, NT = F.G * NWAVES * 64;
    for (int i = gt; i < NB_P * 15 * 128; i += NT) { const int c4 = i & 127, j = (i >> 7) % 15, b = (i >> 7) / 15;
        *(GAS f32x4*)(F.out + O_POOLP + ((size_t)(b * 15 + j) * 512) + 4 * c4) = *(const GAS f32x4*)(U + ((size_t)b * TSEQ + TSEQ - 15 + j) * 512 + 4 * c4); }
    for (int i = gt; i < NB_S * 15 * 128; i += NT) { const int c4 = i & 127, j = (i >> 7) % 15, b = (i >> 7) / 15;
        const f32x4 v = (j < 14) ? *(const GAS f32x4*)(sp + ((size_t)b * 15 + j + 1) * 512 + 4 * c4) : *(const GAS f32x4*)(U + (size_t)(MP + b) * 512 + 4 * c4);
        *(GAS f32x4*)(F.out + O_POOLS + ((size_t)(b * 15 + j) * 512) + 4 * c4) = v; }
}
__device__ __forceinline__ int wq_next(Frame& F, int qword) {
    const unsigned v = __hip_atomic_fetch_add((unsigned*)(F.ctl + qword), F.lane == 0 ? 1u : 0u, __ATOMIC_RELAXED, __HIP_MEMORY_SCOPE_AGENT);
    return (int)__builtin_amdgcn_readfirstlane(v);
}
constexpr int CW_QATT = 8192, CW_QSMP = 8256;
__device__ __forceinline__ void even_mix_phase(Frame& F) {
    const bool streamer = true;
    if (streamer) for (;;) { const int i = wq_next(F, CW_QSMP); if (i >= NB_S * 16) break; sb_sample_item(F, i >> 4, 15 - (i & 15)); }
    for (;;) { const int i = wq_next(F, CW_QATT); if (i >= 4096) break;
        const int grp = i >> 3, bh = grp & 63, qb = 7 - (grp >> 6); sb_prompt_item(F, bh, 8 * qb + 7 - (i & 7)); }
#ifdef DUP_PROMPT
    for (;;) { const int i = wq_next(F, CW_QATT + 128); if (i >= 4096) break;
        const int grp = i >> 3, bh = grp & 63, qb = 7 - (grp >> 6); sb_prompt_item(F, bh, 8 * qb + 7 - (i & 7)); }
#endif
#ifdef DUP_SAMPLE
    for (;;) { const int i = wq_next(F, CW_QSMP + 128); if (i >= NB_S * 16) break; sb_sample_item(F, i >> 4, 15 - (i & 15)); }
#endif
    if (!streamer) for (;;) { const int i = wq_next(F, CW_QSMP); if (i >= NB_S * 16) break; sb_sample_item(F, i >> 4, 15 - (i & 15)); }
    pool_d_rows(F);
#ifdef DUP_POOL
    pool_d_rows(F);
#endif
    pool_state_out(F);
}

constexpr int RK_PITCH = 528, RV_PITCH = 144;
constexpr int R_KL = 0, R_VL = R_KL + 128 * RK_PITCH, R_VD = R_VL + 128 * RV_PITCH, R_SL = R_VD + 128 * RV_PITCH, R_END = R_SL + 256 * RV_PITCH;
static_assert(R_END <= RING_BYTES, "retention LDS map");
__device__ __forceinline__ void ret_prompt_unit(Frame& F, int b, int h, int sl) {
#ifdef STUB_RP
    return;
#endif
    const int w = F.wave, lane = F.lane, tid = F.tid, r32 = lane & 31, hb = lane >> 5;
    const int q4 = (lane & 15) >> 2, p4 = lane & 3, blk = (lane >> 4) & 1;
    const int lt = (w < 4) ? ((0x2130 >> (4 * w)) & 15) : 3 - ((0x2130 >> (4 * (w - 4))) & 15), eh = w >> 2;
    const float gam = 1.0f - __builtin_amdgcn_exp2f(-5.0f - (float)h), lg = __builtin_log2f(gam);
    const size_t row0 = (size_t)b * TSEQ;
    const bf16* Rq = WSP(const bf16, WS_RQ) + row0 * 1024 + h * 256; const bf16* Rk = WSP(const bf16, WS_RK) + row0 * 1024 + h * 256;
    const bf16* Rv = WSP(const bf16, WS_RV) + row0 * 2048 + h * 512 + sl * 64; bf16* Ro = WSP(bf16, WS_RO) + row0 * 2048 + h * 512 + sl * 64;
    LAS unsigned char* KL = F.lds + RING_OFF + R_KL; LAS unsigned char* VL = F.lds + RING_OFF + R_VL; LAS unsigned char* VD = F.lds + RING_OFF + R_VD; LAS unsigned char* SL = F.lds + RING_OFF + R_SL;
    f32x16 sacc[2];
#pragma unroll
    for (int i = 0; i < 16; ++i) { sacc[0][i] = 0.f; sacc[1][i] = 0.f; }
    const float g128 = __builtin_amdgcn_exp2f(128.0f * lg);
    v4u kreg[8], vreg[2]; bf16x8 qf[16];
    const unsigned koff = (unsigned)((tid >> 5) * 1024 + (tid & 31) * 8) * 2u, voff = (unsigned)((tid >> 3) * 2048 + (tid & 7) * 8) * 2u, qoff = (unsigned)(r32 * 1024 + 8 * hb) * 2u;
#pragma unroll
    for (int i = 0; i < 8; ++i) kreg[i] = gld<v4u>(Rk + (size_t)(16 * i) * 1024, koff);
#pragma unroll
    for (int i = 0; i < 2; ++i) vreg[i] = gld<v4u>(Rv + (size_t)(64 * i) * 2048, voff);
#pragma unroll
    for (int s = 0; s < 16; ++s) qf[s] = gld<bf16x8>(Rq + (size_t)(32 * lt) * 1024 + 16 * s, qoff);
    for (int c = 0; c < 16; ++c) {
        WG_BAR();
        float lgc = lg; asm volatile("" : "+v"(lgc));
#pragma unroll
        for (int i = 0; i < 8; ++i) { const int p = tid + 512 * i; *(LAS v4u*)(KL + (p >> 5) * RK_PITCH + (p & 31) * 16) = kreg[i]; }
#pragma unroll
        for (int i = 0; i < 2; ++i) { const int p = tid + 512 * i, row = p >> 3; *(LAS v4u*)(VL + row * RV_PITCH + (p & 7) * 16) = vreg[i];
            const float f = __builtin_amdgcn_exp2f(lgc * (float)(127 - row)); v4u d;
            d.x = pkbf(bflo(vreg[i].x) * f, bfhi(vreg[i].x) * f); d.y = pkbf(bflo(vreg[i].y) * f, bfhi(vreg[i].y) * f); d.z = pkbf(bflo(vreg[i].z) * f, bfhi(vreg[i].z) * f); d.w = pkbf(bflo(vreg[i].w) * f, bfhi(vreg[i].w) * f);
            *(LAS v4u*)(VD + row * RV_PITCH + (p & 7) * 16) = d; }
#pragma unroll
        for (int e2 = 0; e2 < 2; ++e2)
#pragma unroll
            for (int g = 0; g < 4; ++g) { v2u o; o.x = pkbf(sacc[e2][4 * g], sacc[e2][4 * g + 1]); o.y = pkbf(sacc[e2][4 * g + 2], sacc[e2][4 * g + 3]);
                *(LAS v2u*)(SL + (32 * w + r32) * RV_PITCH + (32 * e2 + 8 * g + 4 * hb) * 2) = o; }
        WG_BAR();
        if (c < 15) {
            const bf16* nk = Rk + (size_t)(c + 1) * 128 * 1024; const bf16* nv = Rv + (size_t)(c + 1) * 128 * 2048;
#pragma unroll
            for (int i = 0; i < 8; ++i) kreg[i] = gld<v4u>(nk + (size_t)(16 * i) * 1024, koff);
#pragma unroll
            for (int i = 0; i < 2; ++i) vreg[i] = gld<v4u>(nv + (size_t)(64 * i) * 2048, voff);
        }
        f32x16 acc;
#pragma unroll
        for (int i = 0; i < 16; ++i) acc[i] = 0.f;
#pragma unroll
        for (int s = 0; s < 16; ++s) { const LAS unsigned char* a = SL + (16 * s + 8 * hb + q4) * RV_PITCH + (32 * eh + 16 * blk) * 2 + 8 * p4;
            acc = MFMA32(qf[s], tr_pair(a, a + 4 * RV_PITCH), acc); }
#pragma unroll
        for (int i = 0; i < 16; ++i) acc[i] *= __builtin_amdgcn_exp2f(lgc * (float)(32 * lt + crow(i, hb) + 1));
        for (int mt = 0; mt <= lt; ++mt) {
            f32x16 x;
#pragma unroll
            for (int i = 0; i < 16; ++i) x[i] = 0.f;
#pragma unroll
            for (int s = 0; s < 16; ++s) { const bf16x8 kf = *(const LAS bf16x8*)(KL + (32 * mt + r32) * RK_PITCH + (16 * s + 8 * hb) * 2); x = MFMA32(kf, qf[s], x); }
            float val[16];
#pragma unroll
            for (int i = 0; i < 16; ++i) { const int diff = (32 * lt + r32) - (32 * mt + crow(i, hb)); val[i] = (diff >= 0) ? x[i] * __builtin_amdgcn_exp2f(lgc * (float)diff) : 0.f; }
#pragma unroll
            for (int s2 = 0; s2 < 2; ++s2) { const bf16x8 xs = pack8(val[8 * s2], val[8 * s2 + 1], val[8 * s2 + 2], val[8 * s2 + 3], val[8 * s2 + 4], val[8 * s2 + 5], val[8 * s2 + 6], val[8 * s2 + 7]);
                const LAS unsigned char* a = VL + (32 * mt + 16 * s2 + 4 * hb + q4) * RV_PITCH + (32 * eh + 16 * blk) * 2 + 8 * p4;
                acc = MFMA32(xs, tr_pair(a, a + 8 * RV_PITCH), acc); }
        }
        { bf16* oub = Ro + (size_t)(c * 128 + 32 * lt) * 2048 + 32 * eh; const unsigned ooff = (unsigned)(4 * hb * 2048 + r32) * 2u;
#pragma unroll
          for (int i = 0; i < 16; ++i) gst<bf16>(oub + (size_t)crow(i, 0) * 2048, ooff, (bf16)f2bf(acc[i])); }
        if (c < 15) {
#pragma unroll
            for (int s = 0; s < 16; ++s) qf[s] = gld<bf16x8>(Rq + (size_t)((c + 1) * 128 + 32 * lt) * 1024 + 16 * s, qoff);
        }
#pragma unroll
        for (int i = 0; i < 16; ++i) { sacc[0][i] *= g128; sacc[1][i] *= g128; }
#pragma unroll
        for (int s = 0; s < 8; ++s) {
            const LAS unsigned char* kb = KL + (16 * s + 8 * hb + q4) * RK_PITCH + (32 * w + 16 * blk) * 2 + 8 * p4;
            const bf16x8 pb = tr_pair(kb, kb + 4 * RK_PITCH);
#pragma unroll
            for (int e2 = 0; e2 < 2; ++e2) { const LAS unsigned char* va = VD + (16 * s + 8 * hb + q4) * RV_PITCH + (32 * e2 + 16 * blk) * 2 + 8 * p4;
                sacc[e2] = MFMA32(tr_pair(va, va + 4 * RV_PITCH), pb, sacc[e2]); }
        }
    }
    float* So = F.out + O_RETP + ((size_t)(b * 4 + h) * 256 + 32 * w) * 512 + sl * 64; const unsigned sooff = (unsigned)(r32 * 512 + 4 * hb) * 4u;
#pragma unroll
    for (int e2 = 0; e2 < 2; ++e2)
#pragma unroll
        for (int g = 0; g < 4; ++g) gst<f32x4>(So + 32 * e2 + 8 * g, sooff, (f32x4){sacc[e2][4 * g], sacc[e2][4 * g + 1], sacc[e2][4 * g + 2], sacc[e2][4 * g + 3]});
}
__device__ __forceinline__ void ret_sample_unit(Frame& F, int b, int h) {
#ifdef STUB_RS
    return;
#endif
    const int tid = F.tid, e4 = tid & 127, dg = tid >> 7;
    const float gam = 1.0f - __builtin_amdgcn_exp2f(-5.0f - (float)h);
    const size_t row = (size_t)(MP + b);
    const bf16* Rq = WSP(const bf16, WS_RQ) + row * 1024 + h * 256; const bf16* Rk = WSP(const bf16, WS_RK) + row * 1024 + h * 256;
    const bf16* Rv = WSP(const bf16, WS_RV) + row * 2048 + h * 512; bf16* Ro = WSP(bf16, WS_RO) + row * 2048 + h * 512;
    LAS float* qs = (LAS float*)(F.lds + RING_OFF); LAS float* ks = qs + 256; LAS float* red = ks + 256;
    WG_BAR();
    if (tid < 256) { qs[tid] = bf2f(Rq[tid]); ks[tid] = bf2f(Rk[tid]); }
    const v2u vraw = *(const GAS v2u*)(Rv + 4 * e4); const f32x4 vv = {bflo(vraw.x), bfhi(vraw.x), bflo(vraw.y), bfhi(vraw.y)};
    WG_BAR();
    const float* S0 = INP(I_SRET) + ((size_t)(b * 4 + h) * 256) * 512 + 4 * e4; float* S1 = F.out + O_RETS + ((size_t)(b * 4 + h) * 256) * 512 + 4 * e4;
    f32x4 acc = {0.f, 0.f, 0.f, 0.f};
#pragma unroll 8
    for (int i = 0; i < 64; ++i) { const int d = 4 * i + dg; const f32x4 s = *(const GAS f32x4*)(S0 + (size_t)d * 512);
        acc = acc + s * qs[d]; *(GAS f32x4*)(S1 + (size_t)d * 512) = s * gam + vv * ks[d]; }
    *(LAS f32x4*)(red + dg * 512 + 4 * e4) = acc;
    if (tid < 64) { float s = 0.f;
#pragma unroll
        for (int j = 0; j < 4; ++j) s += qs[tid + 64 * j] * ks[tid + 64 * j];
        s = wave_sum(s); if (tid == 0) red[2048] = s; }
    WG_BAR();
    if (tid < 128) { const f32x4 cr = *(LAS f32x4*)(red + 4 * tid) + *(LAS f32x4*)(red + 512 + 4 * tid) + *(LAS f32x4*)(red + 1024 + 4 * tid) + *(LAS f32x4*)(red + 1536 + 4 * tid);
        const float qk = red[2048]; const f32x4 o = vv * qk + cr * gam;
        v2u w; w.x = pkbf(o.x, o.y); w.y = pkbf(o.z, o.w); *(GAS v2u*)(Ro + 4 * tid) = w; }
}
__device__ __forceinline__ void ret_mix_phase(Frame& F) {
    for (int i = blockIdx.x; i < 256; i += F.G) ret_prompt_unit(F, i >> 5, (i >> 3) & 3, i & 7);
    for (int i = blockIdx.x; i < NB_S * 4; i += F.G) ret_sample_unit(F, i >> 2, i & 3);
}
__device__ __forceinline__ void ret_norm_phase(Frame& F) {
#ifdef STUB_RN
    return;
#endif
    const int gw = blockIdx.x * NWAVES + F.wave, NGW = F.G * NWAVES, lane = F.lane;
    bf16* Ro = WSP(bf16, WS_RO); const bf16* Rg = WSP(const bf16, WS_RG);
    for (int r = gw; r < MR; r += NGW) {
#pragma unroll
        for (int hh = 0; hh < 4; ++hh) {
            const size_t off = (size_t)r * 2048 + hh * 512 + 8 * lane;
            const v4u xr = *(const GAS v4u*)(Ro + off), gr = *(const GAS v4u*)(Rg + off);
            float x[8] = {bflo(xr.x), bfhi(xr.x), bflo(xr.y), bfhi(xr.y), bflo(xr.z), bfhi(xr.z), bflo(xr.w), bfhi(xr.w)};
            const float g[8] = {bflo(gr.x), bfhi(gr.x), bflo(gr.y), bfhi(gr.y), bflo(gr.z), bfhi(gr.z), bflo(gr.w), bfhi(gr.w)};
            float s = 0.f;
#pragma unroll
            for (int e = 0; e < 8; ++e) s += x[e];
            const float mu = wave_sum(s) * (1.0f / 512.0f); float q = 0.f;
#pragma unroll
            for (int e = 0; e < 8; ++e) { x[e] -= mu; q += x[e] * x[e]; }
            const float rs = 1.0f / sqrtf(wave_sum(q) * (1.0f / 512.0f) + 1e-5f);
            v4u o; o.x = pkbf(x[0] * rs * g[0], x[1] * rs * g[1]); o.y = pkbf(x[2] * rs * g[2], x[3] * rs * g[3]); o.z = pkbf(x[4] * rs * g[4], x[5] * rs * g[5]); o.w = pkbf(x[6] * rs * g[6], x[7] * rs * g[7]);
            *(GAS v4u*)(Ro + off) = o;
        }
    }
}
constexpr int N_PHASES = 25;
__global__ void __launch_bounds__(NWAVES * 64, 2) fwd(Args args) {
    extern __shared__ __attribute__((aligned(16))) unsigned char lds[];
    Frame F;
    F.lds = (LAS unsigned char*)lds;
    F.MISC = (volatile LAS unsigned*)(F.lds + MISC_OFF);
    F.tid = threadIdx.x; F.lane = F.tid & 63; F.wave = __builtin_amdgcn_readfirstlane(F.tid >> 6);
    F.G = gridDim.x;
    F.ws = args.ws; F.out = args.out; F.ctl = (gu32*)(args.ws + WS_CTL);
    for (int u = F.tid; u < (LDS_BYTES - LDSCTL_OFF) / 4; u += NWAVES * 64) ((LAS unsigned*)(F.lds + LDSCTL_OFF))[u] = 0u;
    __syncthreads();
    const int lo = args.ph_lo, hi = args.ph_hi;
    const bool use_bar = (hi - lo) > 1;
    XcdBarrier bar; bar.bar = (unsigned*)(F.ctl + CW_BAR); bar.x = 0; bar.st = nullptr;
    if (use_bar) bar = xcd_barrier_post((unsigned*)(F.ctl + CW_BAR), F.MISC + 8);
    int p = 0;
#ifndef PROBE_MASK
#define PROBE_MASK 0u
#endif
    unsigned long long pb0 = 0, pb = 0;
#define PRB_BEGIN if (PROBE_MASK != 0u) { if ((PROBE_MASK >> p) & 1u) pb0 = __builtin_amdgcn_s_memrealtime(); }
#define PRB_END if (PROBE_MASK != 0u) { if ((PROBE_MASK >> p) & 1u) pb += __builtin_amdgcn_s_memrealtime() - pb0; }
#define PH_BEGIN PRB_BEGIN if (p >= lo && p < hi) { asm volatile("" : "+s"(F.ws), "+s"(cu)); asm volatile("" : "+v"(F.tid)); F.lane = F.tid & 63; F.wave = __builtin_amdgcn_readfirstlane(F.tid >> 6);
#define PH_END } if (p >= lo && p + 1 < hi) xcd_barrier(bar); PRB_END ++p;
    using namespace pg8;
    PG8_LAS unsigned char* ring = F.lds + RING_OFF;
    int cu = (int)blockIdx.x;

    PH_BEGIN conv_set(F, 0, (int)blockIdx.x * NWAVES + F.wave, F.G * NWAVES); PH_END
    PH_BEGIN { Gemm g{WSP(bf16, WS_COND), WSP(bf16, WS_WADA), 256, 18432, 1024}; MixOrder S; S.init(1, 18432, 1024, 0, F.G, cu);
        EpiMod E{WSP(float, WS_MODT), INP(I_BADA), INP(I_NPRE), INP(I_NPOST), NB_TOT};
        gemm_phase<EpiMod, MixOrder, true, true>(ring, g, S, E); conv_in_tail(F, 4, 72); } PH_END
    PH_BEGIN seam_phase(F, true, false, true, 0, 0, 1); PH_END

#pragma unroll
    for (int l = 0; l < 2; ++l) {
#pragma unroll
        for (int s = 0; s < 3; ++s) {
            if (s != 1) {
                const int lf = l * 2 + (s >> 1);
                PH_BEGIN { Gemm g{WSP(bf16, WS_H), WSP(bf16, WS_WFIN + lf * WFIN_SZ), MPAD, 5632, 1024}; MixOrder S; S.init(64, 5632, 1024, 1, F.G, cu);
                    EpiSwiGLU E{WSP(bf16, WS_G), DFF};
                    gemm_phase<EpiSwiGLU, MixOrder, true, true>(ring, g, S, E); if (lf < 3) conv_in_tail(F, lf + 1, 64 * 22 + 22); } PH_END
                PH_BEGIN { Gemm g{WSP(bf16, WS_G), WSP(bf16, WS_WFOUT + lf * WFOUT_SZ), MPAD, 1024, DFF}; MixOrder S; S.init(64, 1024, DFF, 11, F.G, cu);
                    EpiF32 E{WSP(float, WS_Y), 1024, DFF / 64, WSP(float, WS_YS)};
                    gemm_phase<EpiF32, MixOrder, true, true>(ring, g, S, E); } PH_END
            } else if (l == 0) {
                PH_BEGIN { Gemm g{WSP(bf16, WS_H), WSP(bf16, WS_WEI), MPAD, 2048, 1024}; MixOrder S; S.init(64, 2048, 1024, 1, F.G, cu);
                    EpiEvenIn E{WSP(bf16, WS_Q), WSP(bf16, WS_KB), WSP(bf16, WS_VB), WSP(float, WS_U), F.out + O_KP, F.out + O_VP, F.out + O_KS, F.out + O_VS, 0.125f * LOG2E, MP, MR};
                    gemm_phase<EpiEvenIn, MixOrder, true, true>(ring, g, S, E); } PH_END
                PH_BEGIN even_mix_phase(F); PH_END
                PH_BEGIN { even_post_phase(F);
                    Gemm g{WSP(bf16, WS_D), WSP(bf16, WS_WPOOL), MPAD, 512, 512}; MixOrder S; S.init(64, 512, 512, 1, F.G, cu);
                    EpiPool E{WSP(bf16, WS_O), INP(I_PS)};
                    gemm_phase<EpiPool, MixOrder, true, true>(ring, g, S, E); } PH_END
                PH_BEGIN { Gemm g{WSP(bf16, WS_O), WSP(bf16, WS_WEO), MPAD, 1024, 1024}; MixOrder S; S.init(64, 1024, 1024, 4, F.G, cu);
                    EpiF32 E{WSP(float, WS_Y), 1024, 16, WSP(float, WS_YS)};
                    gemm_phase<EpiF32, MixOrder, true, true>(ring, g, S, E); } PH_END
            } else {
                PH_BEGIN { Gemm g{WSP(bf16, WS_H), WSP(bf16, WS_WOI), MPAD, 6144, 1024}; MixOrder S; S.init(64, 6144, 1024, 1, F.G, cu);
                    EpiOddIn E{WSP(bf16, WS_RQ), WSP(bf16, WS_RK), WSP(bf16, WS_RV), WSP(bf16, WS_RG), MP};
                    gemm_phase<EpiOddIn, MixOrder, true, true>(ring, g, S, E); } PH_END
                PH_BEGIN ret_mix_phase(F); PH_END
                PH_BEGIN ret_norm_phase(F); PH_END
                PH_BEGIN { Gemm g{WSP(bf16, WS_RO), WSP(bf16, WS_WOO), MPAD, 1024, 2048}; MixOrder S; S.init(64, 1024, 2048, 8, F.G, cu);
                    EpiF32 E{WSP(float, WS_Y), 1024, 32, WSP(float, WS_YS)};
                    gemm_phase<EpiF32, MixOrder, true, true>(ring, g, S, E); } PH_END
            }
            PH_BEGIN { const bool last = (l == 1 && s == 2); const int nl = (s == 2) ? l + 1 : l, ns = (s == 2) ? 0 : s + 1;
                seam_phase(F, l == 0 && s == 0, true, !last, l * 9216 + s * 3072, last ? 0 : nl * 9216 + ns * 3072, s != 1 ? 11 : (l == 0 ? 4 : 8)); } PH_END
        }
    }
#undef PH_BEGIN
#undef PH_END
    if (PROBE_MASK != 0u && blockIdx.x == 0 && F.tid == 0) {
        const unsigned long long want = 102400ull * (pb / 800ull), t0 = __builtin_amdgcn_s_memrealtime();
        while (__builtin_amdgcn_s_memrealtime() - t0 < want) __builtin_amdgcn_s_sleep(16);
    }
}

#ifndef MK_PER_PHASE
#define MK_PER_PHASE 0
#endif
extern "C" void kernel_launch(void* const* d_in, const int* in_sizes, int n_in, void* d_out, int out_size, void* d_ws, size_t ws_size, hipStream_t stream) {
    static int grid = 0;
    if (grid == 0) {
        if (n_in != N_IN || (size_t)out_size != O_END || ws_size < WS_END) { fprintf(stderr, "kernel_launch: unexpected shapes (n_in %d out %d ws %zu)\n", n_in, out_size, ws_size); grid = -1; return; }
        int dev = 0, cus = 0, per_cu = 0;
        if (hipGetDevice(&dev) != hipSuccess || hipDeviceGetAttribute(&cus, hipDeviceAttributeMultiprocessorCount, dev) != hipSuccess) { grid = -1; return; }
        if (hipFuncSetAttribute((const void*)fwd, hipFuncAttributeMaxDynamicSharedMemorySize, LDS_BYTES) != hipSuccess) { fprintf(stderr, "kernel_launch: hipFuncSetAttribute failed\n"); grid = -1; return; }
        if (hipOccupancyMaxActiveBlocksPerMultiprocessor(&per_cu, (const void*)fwd, NWAVES * 64, LDS_BYTES) != hipSuccess || per_cu < 1)
            fprintf(stderr, "kernel_launch: note: occupancy query reports %d workgroups per CU\n", per_cu);
        (void)hipGetLastError();
        grid = cus;
    }
    if (grid < 0) return;
    (void)hipMemsetAsync((char*)d_ws + WS_CTL, 0, CTL_ZERO_BYTES, stream);
    Args a{};
    for (int i = 0; i < N_IN; ++i) a.in[i] = (const float*)d_in[i];
    a.out = (float*)d_out; a.ws = (unsigned char*)d_ws;
#if MK_PER_PHASE
    for (int p = 0; p < N_PHASES; ++p) { a.ph_lo = p; a.ph_hi = p + 1; hipLaunchKernelGGL(fwd, dim3(grid), dim3(NWAVES * 64), LDS_BYTES, stream, a); }
#else
    a.ph_lo = 0; a.ph_hi = N_PHASES;
    hipLaunchKernelGGL(fwd, dim3(grid), dim3(NWAVES * 64), LDS_BYTES, stream, a);
#endif
    const hipError_t le = hipPeekAtLastError();
    if (le != hipSuccess) fprintf(stderr, "kernel_launch: launch failed: %s\n", hipGetErrorName(le));
}
```

```cpp
#include <hip/hip_runtime.h>
#include <cstdio>
#include <cstdint>
namespace pg8 {
#define PG8_LAS __attribute__((address_space(3)))
typedef unsigned short bf16_t;
typedef short bf16x8 __attribute__((ext_vector_type(8)));
typedef float f32x4 __attribute__((ext_vector_type(4)));
typedef unsigned u32x4 __attribute__((ext_vector_type(4)));
constexpr int BM = 256, BK = 64, HALF = 128, HTB = HALF * BK * 2  , STAGE_BYTES = 8 * HTB, NXCD = 8, WGM = 8;

__host__ __device__ __forceinline__ int lds_byte(int r, int c) { const int st = (r >> 4) * 2 + (c >> 5), rr = r & 15, cc = c & 31, ob = rr * 64 + cc * 2; return st * 1024 + (ob ^ (((ob >> 9) & 1) << 5)); }
__host__ __device__ __forceinline__ void stage_rc(int b, int& R, int& C) { const int st = b / 1024, sb = b % 1024, swz = sb ^ (((sb >> 9) & 1) << 5); R = (st >> 1) * 16 + swz / 64; C = (st & 1) * 32 + (swz % 64) / 2; }
__host__ __device__ __forceinline__ int perm32(int rho) { const int n = rho >> 4, i = rho & 15; return 8 * (i >> 2) + 4 * n + (i & 3); }

struct Unit { int pm, pn, kt0, nt; };
struct Gemm { const bf16_t* A; const bf16_t* Bt; int M, N, K; };

struct MixOrder {
    int nMp, nN, nP, nS, G, c, ntf, ks;
    __host__ __device__ void init(int nMp_, int N, int K, int ks_, int G_, int c_) { nMp = nMp_; nN = N / BM; nP = nMp * nN; ks = ks_; nS = nN * ks; G = G_; c = c_; ntf = K / BK; }
    __host__ __device__ bool next(int i, Unit& u) const {
        const long L = (long)i * G + c; if (L >= nP + nS) return false;
        int wgid = (int)L; { const int q = nP / NXCD, r = nP % NXCD, xcd = wgid % NXCD, off = wgid / NXCD; wgid = (xcd < r ? xcd * (q + 1) : r * (q + 1) + (xcd - r) * q) + off; }
        const int nig = WGM * nN, gid = wgid / nig, fm = gid * WGM, gsz = (nMp - fm) < WGM ? (nMp - fm) : WGM;
        const int ppm = fm + ((wgid % nig) % (gsz > 0 ? gsz : 1)), ppn = (wgid % nig) / (gsz > 0 ? gsz : 1);
        const bool smp = L >= nP; const int kss = ks > 0 ? ks : 1; const int j = (int)L - nP, spn = j / kss, snt = ntf / kss;
        u.pm = smp ? nMp : ppm; u.pn = smp ? spn : ppn; u.kt0 = smp ? (j - spn * kss) * snt : 0; u.nt = smp ? snt : ntf; return true;
    }
    __device__ __forceinline__ void a_ready(const Unit&) const {}
    __device__ __forceinline__ void done(const Unit&) const {}
};
__device__ __forceinline__ unsigned cvt_pk_bf16(float lo, float hi) { unsigned r; asm volatile("v_cvt_pk_bf16_f32 %0, %1, %2" : "=v"(r) : "v"(lo), "v"(hi)); return r; }
typedef unsigned u32x2 __attribute__((ext_vector_type(2)));
__device__ __forceinline__ float fast_rcp(float x) { return __builtin_amdgcn_rcpf(x); }
__device__ __forceinline__ float silu_f(float x) { return x * fast_rcp(1.0f + __builtin_amdgcn_exp2f(-1.4426950408889634f * x)); }

struct EpiMod {
    static constexpr bool PERM = false, AFTER_DRAIN = false;
    float* out; const float* b_ada; const float* norm_pre; const float* norm_post; int nrows;
    __device__ __forceinline__ void operator()(const f32x4 (&acc)[2][2][4][2], const Unit& u, int wr, int wc, int fr, int fq) const {
        const int ct = u.pn * BM; const int l = ct / 9216, cc0 = ct - l * 9216, sub = cc0 / 3072, j = (cc0 - sub * 3072) >> 10, d0 = cc0 & 1023;
        const float resw = (sub == 1) ? 1.0f : 0.5f;
#pragma unroll
        for (int bj = 0; bj < 2; ++bj)
#pragma unroll
            for (int n = 0; n < 2; ++n) {
                const int col = bj * HALF + wc * 32 + n * 16 + 4 * fq, gcol = ct + col, d = d0 + col;
                const f32x4 bias = *(const f32x4*)(b_ada + gcol);
                f32x4 gv = (f32x4){0.f, 0.f, 0.f, 0.f};
                if (j == 1) gv = *(const f32x4*)(norm_pre + (l * 3 + sub) * 1024 + d);
                if (j == 2) gv = *(const f32x4*)(norm_post + (l * 3 + sub) * 1024 + d) * resw;
#pragma unroll
                for (int ai = 0; ai < 2; ++ai)
#pragma unroll
                    for (int m = 0; m < 4; ++m) { const int row = ai * HALF + wr * 64 + m * 16 + fr;
                        f32x4 v = acc[ai][bj][m][n] + bias;
                        if (j == 1) v = gv * (v + 1.0f);
                        if (j == 2) v = gv * v;
                        if (row < nrows) *(f32x4*)(out + (size_t)row * 18432 + gcol) = v; }
            }
    }
};
struct EpiSwiGLU {
    static constexpr bool PERM = true, AFTER_DRAIN = false;
    bf16_t* G; int ldg;
    __device__ __forceinline__ void operator()(const f32x4 (&acc)[2][2][4][2], const Unit& u, int wr, int wc, int fr, int fq) const {
        const int col0 = u.pn * HALF + wc * 32 + 8 * fq;
#pragma unroll
        for (int ai = 0; ai < 2; ++ai)
#pragma unroll
            for (int m = 0; m < 4; ++m) { const int row = u.pm * BM + ai * HALF + wr * 64 + m * 16 + fr;
                float o[8];
#pragma unroll
                for (int n = 0; n < 2; ++n) {
                    const f32x4 g = acc[ai][0][m][n], up = acc[ai][1][m][n]; const f32x4 t = g * (-1.4426950408889634f);
                    f32x4 ex; ex[0] = __builtin_amdgcn_exp2f(t[0]); ex[1] = __builtin_amdgcn_exp2f(t[1]); ex[2] = __builtin_amdgcn_exp2f(t[2]); ex[3] = __builtin_amdgcn_exp2f(t[3]);
                    const f32x4 d = ex + 1.0f;
                    f32x4 r; r[0] = __builtin_amdgcn_rcpf(d[0]); r[1] = __builtin_amdgcn_rcpf(d[1]); r[2] = __builtin_amdgcn_rcpf(d[2]); r[3] = __builtin_amdgcn_rcpf(d[3]);
                    const f32x4 s = (g * r) * up;
                    o[n * 4 + 0] = s[0]; o[n * 4 + 1] = s[1]; o[n * 4 + 2] = s[2]; o[n * 4 + 3] = s[3]; }
                u32x4 w; w.x = cvt_pk_bf16(o[0], o[1]); w.y = cvt_pk_bf16(o[2], o[3]); w.z = cvt_pk_bf16(o[4], o[5]); w.w = cvt_pk_bf16(o[6], o[7]);
                *(u32x4*)(G + (size_t)row * ldg + col0) = w; }
    }
};
struct EpiY {
    static constexpr bool PERM = true, AFTER_DRAIN = false;
    bf16_t* Y; int ldc; int ntf; float* Ys;
    __device__ __forceinline__ void operator()(const f32x4 (&acc)[2][2][4][2], const Unit& u, int wr, int wc, int fr, int fq) const {
        if (u.nt == ntf) {
#pragma unroll
            for (int ai = 0; ai < 2; ++ai)
#pragma unroll
                for (int m = 0; m < 4; ++m) { bf16_t* rowp = Y + (size_t)(u.pm * BM + ai * HALF + wr * 64 + m * 16 + fr) * ldc + u.pn * BM + wc * 32 + 8 * fq;
#pragma unroll
                    for (int bj = 0; bj < 2; ++bj) { const f32x4 a = acc[ai][bj][m][0], b = acc[ai][bj][m][1];
                        u32x4 w; w.x = cvt_pk_bf16(a[0], a[1]); w.y = cvt_pk_bf16(a[2], a[3]); w.z = cvt_pk_bf16(b[0], b[1]); w.w = cvt_pk_bf16(b[2], b[3]);
                        *(u32x4*)(rowp + bj * HALF) = w; } }
        } else {
            const int kq = u.kt0 / u.nt;
#pragma unroll
            for (int m = 0; m < 4; ++m) { float* rowp = Ys + ((size_t)kq * HALF + wr * 64 + m * 16 + fr) * ldc + u.pn * BM + wc * 32 + 8 * fq;
#pragma unroll
                for (int bj = 0; bj < 2; ++bj)
#pragma unroll
                    for (int n = 0; n < 2; ++n) *(f32x4*)(rowp + bj * HALF + n * 4) = acc[0][bj][m][n]; }
        }
    }
};
struct EpiEvenIn {
    static constexpr bool PERM = false, AFTER_DRAIN = false;
    bf16_t *Q, *Kb, *Vb; float* U; float *kp, *vp, *ks, *vs; float qscale; int mp, mtot;
    __device__ __forceinline__ void operator()(const f32x4 (&acc)[2][2][4][2], const Unit& u, int wr, int wc, int fr, int fq) const {
        const int t = u.pn >> 1, c0 = (u.pn & 1) * BM + wc * 32 + 4 * fq;
#pragma unroll
        for (int ai = 0; ai < 2; ++ai)
#pragma unroll
            for (int m = 0; m < 4; ++m) { const int row = u.pm * BM + ai * HALF + wr * 64 + m * 16 + fr;
#pragma unroll
                for (int bj = 0; bj < 2; ++bj)
#pragma unroll
                    for (int n = 0; n < 2; ++n) { const int c = c0 + bj * HALF + n * 16; const f32x4 v = acc[ai][bj][m][n];
                        if (t == 0) { const f32x4 s = v * qscale; u32x2 w; w.x = cvt_pk_bf16(s[0], s[1]); w.y = cvt_pk_bf16(s[2], s[3]); *(u32x2*)(Q + (size_t)row * 512 + c) = w; }
                        else if (t == 3) { *(f32x4*)(U + (size_t)row * 512 + c) = v; }
                        else { u32x2 w; w.x = cvt_pk_bf16(v[0], v[1]); w.y = cvt_pk_bf16(v[2], v[3]); *(u32x2*)((t == 1 ? Kb : Vb) + (size_t)row * 512 + c) = w;
                            if (row < mp) *(f32x4*)((t == 1 ? kp : vp) + (size_t)row * 512 + c) = v;
                            else if (row < mtot) *(f32x4*)((t == 1 ? ks : vs) + (size_t)(row - mp) * 512 + c) = v; } }
            }
    }
};
struct EpiOddIn {
    static constexpr bool PERM = true, AFTER_DRAIN = false;
    bf16_t *Rq, *Rk, *Rv, *Rg; int mp;
    __device__ __forceinline__ void operator()(const f32x4 (&acc)[2][2][4][2], const Unit& u, int wr, int wc, int fr, int fq) const {
        const int i0 = wc * 32 + 8 * fq;
        if (u.pn < 8) {
            bf16_t* dst = (u.pn < 4 ? Rq : Rk) + (u.pn & 3) * 256; const float osc = (u.pn < 4) ? 1.0f : 0.0625f;
            float invr[8];
#pragma unroll
            for (int q = 0; q < 8; ++q) invr[q] = __builtin_amdgcn_exp2f(-(float)(i0 + q) * (13.287712379549449f / 128.0f)) * 0.15915494309189535f;
#pragma unroll
            for (int ai = 0; ai < 2; ++ai)
#pragma unroll
                for (int m = 0; m < 4; ++m) { const int row = u.pm * BM + ai * HALF + wr * 64 + m * 16 + fr; const float pos = (row < mp) ? (float)(row & 2047) : 2048.0f;
                    float o1[8], o2[8];
#pragma unroll
                    for (int q = 0; q < 8; ++q) { float rev = pos * invr[q]; rev = rev - __builtin_rintf(rev);
                        const float sn = __builtin_amdgcn_sinf(rev), cs = __builtin_amdgcn_cosf(rev);
                        const float x1 = acc[ai][0][m][q >> 2][q & 3], x2 = acc[ai][1][m][q >> 2][q & 3];
                        o1[q] = (x1 * cs - x2 * sn) * osc; o2[q] = (x1 * sn + x2 * cs) * osc; }
                    u32x4 w1, w2; w1.x = cvt_pk_bf16(o1[0], o1[1]); w1.y = cvt_pk_bf16(o1[2], o1[3]); w1.z = cvt_pk_bf16(o1[4], o1[5]); w1.w = cvt_pk_bf16(o1[6], o1[7]);
                    w2.x = cvt_pk_bf16(o2[0], o2[1]); w2.y = cvt_pk_bf16(o2[2], o2[3]); w2.z = cvt_pk_bf16(o2[4], o2[5]); w2.w = cvt_pk_bf16(o2[6], o2[7]);
                    *(u32x4*)(dst + (size_t)row * 1024 + i0) = w1; *(u32x4*)(dst + (size_t)row * 1024 + 128 + i0) = w2; }
        } else {
            const bool isg = u.pn >= 16; bf16_t* dst = (isg ? Rg : Rv) + ((u.pn - 8) & 7) * 256;
#pragma unroll
            for (int ai = 0; ai < 2; ++ai)
#pragma unroll
                for (int m = 0; m < 4; ++m) { const int row = u.pm * BM + ai * HALF + wr * 64 + m * 16 + fr;
#pragma unroll
                    for (int bj = 0; bj < 2; ++bj) { float o[8];
#pragma unroll
                        for (int q = 0; q < 8; ++q) { const float x = acc[ai][bj][m][q >> 2][q & 3]; o[q] = isg ? silu_f(x) : x; }
                        u32x4 w; w.x = cvt_pk_bf16(o[0], o[1]); w.y = cvt_pk_bf16(o[2], o[3]); w.z = cvt_pk_bf16(o[4], o[5]); w.w = cvt_pk_bf16(o[6], o[7]);
                        *(u32x4*)(dst + (size_t)row * 2048 + bj * HALF + i0) = w; } }
        }
    }
};
struct EpiPool {
    static constexpr bool PERM = true, AFTER_DRAIN = false;
    bf16_t* O; const float* pscale;
    __device__ __forceinline__ void operator()(const f32x4 (&acc)[2][2][4][2], const Unit& u, int wr, int wc, int fr, int fq) const {
#pragma unroll
        for (int bj = 0; bj < 2; ++bj) { const int c0 = u.pn * BM + bj * HALF + wc * 32 + 8 * fq;
            const f32x4 s0 = *(const f32x4*)(pscale + c0), s1 = *(const f32x4*)(pscale + c0 + 4);
#pragma unroll
            for (int ai = 0; ai < 2; ++ai)
#pragma unroll
                for (int m = 0; m < 4; ++m) { const int row = u.pm * BM + ai * HALF + wr * 64 + m * 16 + fr;
                    const f32x4 a = acc[ai][bj][m][0] * s0, b = acc[ai][bj][m][1] * s1;
                    u32x4 w; w.x = cvt_pk_bf16(a[0], a[1]); w.y = cvt_pk_bf16(a[2], a[3]); w.z = cvt_pk_bf16(b[0], b[1]); w.w = cvt_pk_bf16(b[2], b[3]);
                    *(u32x4*)(O + (size_t)row * 1024 + 512 + c0) = w; } }
    }
};
template <class Epi, class Sched, bool ALIGN_EPI = false, bool SP2 = false>
__device__ __forceinline__ void gemm_phase(PG8_LAS unsigned char* lds, const Gemm g, const Sched& S, const Epi& E, int tid_in) {
    int tid_ = tid_in; asm volatile("" : "+v"(tid_));
    const int tid = tid_, wid = __builtin_amdgcn_readfirstlane(tid >> 6), lane = tid & 63, wr = wid >> 2, wc = wid & 3, fr = lane & 15, fq = lane >> 4;
    const int K = g.K;
    unsigned voffA[2], voffB[2];
#pragma unroll
    for (int i = 0; i < 2; ++i) { int R, C; stage_rc(tid * 16 + i * 8192, R, C); const int Rb = Epi::PERM ? ((R & ~31) + perm32(R & 31)) : R;
        voffA[i] = (unsigned)(R * K + C) * 2u; voffB[i] = (unsigned)(Rb * K + C) * 2u; }
    const size_t kstep = (size_t)(BK * 2);
    const size_t hstep = (size_t)HALF * K * 2;
    const size_t tstep = 2 * hstep;
    const unsigned ldsw = (unsigned)wid * 1024u;
    const int aoff = lds_byte(wr * 64 + fr, fq * 8), boff = lds_byte(wc * 32 + fr, fq * 8);
#define PG8_SA(b, h) (((b) * 2 + (h)) * HTB)
#define PG8_SB(b, h) ((4 + (b) * 2 + (h)) * HTB)
#define PG8_STAGE(bufoff, gbase, voff) do { _Pragma("unroll") for (int _i = 0; _i < 2; ++_i) \
        __builtin_amdgcn_global_load_lds((const unsigned*)((const char*)(gbase) + (voff)[_i]), (PG8_LAS unsigned*)(lds + (bufoff) + ldsw + _i * 8192), 16, 0, 0); } while (0)
#define PG8_LDA(dst, b, h) do { _Pragma("unroll") for (int m = 0; m < 4; ++m) _Pragma("unroll") for (int k = 0; k < 2; ++k) dst[m][k] = *(const PG8_LAS bf16x8*)(lds + PG8_SA(b, h) + aoff + m * 2048 + k * 1024); } while (0)
#define PG8_LDB(dst, b, h) do { _Pragma("unroll") for (int n = 0; n < 2; ++n) _Pragma("unroll") for (int k = 0; k < 2; ++k) dst[n][k] = *(const PG8_LAS bf16x8*)(lds + PG8_SB(b, h) + boff + n * 2048 + k * 1024); } while (0)
#define PG8_MMA(ai, bj, At, Bt) do { __builtin_amdgcn_s_setprio(1); _Pragma("unroll") for (int m = 0; m < 4; ++m) _Pragma("unroll") for (int n = 0; n < 2; ++n) _Pragma("unroll") for (int k = 0; k < 2; ++k) \
        acc[ai][bj][m][n] = __builtin_amdgcn_mfma_f32_16x16x32_bf16(Bt[n][k], At[m][k], acc[ai][bj][m][n], 0, 0, 0); __builtin_amdgcn_s_setprio(0); } while (0)
#define PG8_WAIT_V(n) asm volatile("s_waitcnt vmcnt(" #n ")" ::: "memory")
#define PG8_WAIT_L(n) asm volatile("s_waitcnt lgkmcnt(" #n ")" ::: "memory")
#define PG8_BAR __builtin_amdgcn_s_barrier()
#define PG8_SCHED __builtin_amdgcn_sched_barrier(0)
    Unit cur, nxt; int ui = 0;
    if (!S.next(0, cur)) return;
    f32x4 acc[2][2][4][2];
#pragma unroll
    for (int a = 0; a < 2; ++a)
#pragma unroll
        for (int b = 0; b < 2; ++b)
#pragma unroll
            for (int m = 0; m < 4; ++m)
#pragma unroll
                for (int n = 0; n < 2; ++n) acc[a][b][m][n] = (f32x4){0.f, 0.f, 0.f, 0.f};
    bf16x8 At[4][2], B0[2][2], B1[2][2];
    const char* cA = (const char*)g.A + (size_t)cur.pm * tstep + (size_t)cur.kt0 * kstep; const char* cB = (const char*)g.Bt + (size_t)cur.pn * tstep + (size_t)cur.kt0 * kstep;
    S.a_ready(cur);
    if constexpr (SP2) {
        PG8_STAGE(PG8_SB(0, 0), cB, voffB); PG8_STAGE(PG8_SB(0, 1), cB + hstep, voffB); PG8_STAGE(PG8_SA(0, 0), cA, voffA); PG8_STAGE(PG8_SA(0, 1), cA + hstep, voffA);
        if (wr == 1) PG8_BAR;
        PG8_WAIT_V(2); PG8_BAR;
        PG8_STAGE(PG8_SB(1, 0), cB + kstep, voffB); PG8_STAGE(PG8_SA(1, 0), cA + kstep, voffA); PG8_STAGE(PG8_SB(1, 1), cB + hstep + kstep, voffB);
        PG8_WAIT_V(6); PG8_BAR;
    } else {
        PG8_STAGE(PG8_SB(0, 0), cB, voffB); PG8_STAGE(PG8_SA(0, 0), cA, voffA); PG8_STAGE(PG8_SB(0, 1), cB + hstep, voffB); PG8_STAGE(PG8_SA(0, 1), cA + hstep, voffA);
        if (wr == 1) PG8_BAR;
        PG8_WAIT_V(4); PG8_BAR;
        PG8_STAGE(PG8_SB(1, 0), cB + kstep, voffB); PG8_STAGE(PG8_SA(1, 0), cA + kstep, voffA); PG8_STAGE(PG8_SB(1, 1), cB + hstep + kstep, voffB);
        PG8_WAIT_V(6); PG8_BAR;
    }
    for (;;) {
        const bool has_next = S.next(ui + 1, nxt);
        const char* nA = has_next ? (const char*)g.A + (size_t)nxt.pm * tstep + (size_t)nxt.kt0 * kstep : cA; const char* nB = has_next ? (const char*)g.Bt + (size_t)nxt.pn * tstep + (size_t)nxt.kt0 * kstep : cB;
        const int nt = cur.nt;
        for (int t = 0; t < nt; t += 2) {
            const bool last = (t == nt - 2);
            const char* a1 = cA + (size_t)(t + 1) * kstep;
            const char* a2 = last ? nA : cA + (size_t)(t + 2) * kstep; const char* b2 = last ? nB : cB + (size_t)(t + 2) * kstep;
            const char* a3 = a2 + kstep; const char* b3 = b2 + kstep;
            if (last && has_next) S.a_ready(nxt);
            if constexpr (SP2) {
            PG8_LDB(B0, 0, 0); PG8_LDB(B1, 0, 1); PG8_SCHED; PG8_LDA(At, 0, 0); PG8_STAGE(PG8_SA(1, 1), a1 + hstep, voffA);
            PG8_WAIT_V(8); PG8_WAIT_L(0); PG8_BAR; PG8_MMA(0, 0, At, B0); PG8_MMA(0, 1, At, B1); PG8_BAR; PG8_SCHED;
            PG8_LDA(At, 0, 1); PG8_STAGE(PG8_SB(0, 0), b2, voffB); PG8_STAGE(PG8_SB(0, 1), b2 + hstep, voffB); PG8_STAGE(PG8_SA(0, 0), a2, voffA);
            PG8_WAIT_V(8); PG8_WAIT_L(0); PG8_BAR; PG8_MMA(1, 0, At, B0); PG8_MMA(1, 1, At, B1); PG8_BAR; PG8_SCHED;
            PG8_LDB(B0, 1, 0); PG8_LDB(B1, 1, 1); PG8_SCHED; PG8_LDA(At, 1, 0); PG8_STAGE(PG8_SA(0, 1), a2 + hstep, voffA);
            PG8_WAIT_V(8); PG8_WAIT_L(0); PG8_BAR; PG8_MMA(0, 0, At, B0); PG8_MMA(0, 1, At, B1); PG8_BAR; PG8_SCHED;
            PG8_LDA(At, 1, 1); PG8_STAGE(PG8_SB(1, 0), b3, voffB); PG8_STAGE(PG8_SB(1, 1), b3 + hstep, voffB); PG8_STAGE(PG8_SA(1, 0), a3, voffA);
            PG8_WAIT_V(8); PG8_WAIT_L(0); PG8_BAR; PG8_MMA(1, 0, At, B0); PG8_MMA(1, 1, At, B1); PG8_BAR; PG8_SCHED;
            } else {
            PG8_LDB(B0, 0, 0); PG8_SCHED; PG8_LDA(At, 0, 0); PG8_STAGE(PG8_SA(1, 1), a1 + hstep, voffA);
            PG8_WAIT_L(8); PG8_BAR; PG8_WAIT_L(0); PG8_MMA(0, 0, At, B0); PG8_BAR; PG8_SCHED;
            PG8_LDB(B1, 0, 1); PG8_STAGE(PG8_SB(0, 0), b2, voffB);
            PG8_BAR; PG8_WAIT_L(0); PG8_MMA(0, 1, At, B1); PG8_BAR;
            PG8_LDA(At, 0, 1); PG8_STAGE(PG8_SA(0, 0), a2, voffA);
            PG8_BAR; PG8_WAIT_L(0); PG8_MMA(1, 0, At, B0); PG8_BAR; PG8_SCHED;
            PG8_STAGE(PG8_SB(0, 1), b2 + hstep, voffB);
            PG8_WAIT_V(6); PG8_BAR; PG8_MMA(1, 1, At, B1); PG8_BAR;
            PG8_LDB(B0, 1, 0); PG8_SCHED; PG8_LDA(At, 1, 0); PG8_STAGE(PG8_SA(0, 1), a2 + hstep, voffA);
            PG8_WAIT_L(8); PG8_BAR; PG8_WAIT_L(0); PG8_MMA(0, 0, At, B0); PG8_BAR; PG8_SCHED;
            PG8_LDB(B1, 1, 1); PG8_STAGE(PG8_SB(1, 0), b3, voffB);
            PG8_BAR; PG8_WAIT_L(0); PG8_MMA(0, 1, At, B1); PG8_BAR;
            PG8_LDA(At, 1, 1); PG8_STAGE(PG8_SA(1, 0), a3, voffA);
            PG8_BAR; PG8_WAIT_L(0); PG8_MMA(1, 0, At, B0); PG8_BAR; PG8_SCHED;
            PG8_STAGE(PG8_SB(1, 1), b3 + hstep, voffB);
            PG8_WAIT_V(6); PG8_BAR; PG8_MMA(1, 1, At, B1); PG8_BAR;
            }
        }
        if constexpr (ALIGN_EPI) { if (wr == 0) PG8_BAR; }
        if constexpr (!Epi::AFTER_DRAIN) { E(acc, cur, wr, wc, fr, fq); S.done(cur); }
        if (!has_next) break;
#pragma unroll
        for (int a = 0; a < 2; ++a)
#pragma unroll
            for (int b = 0; b < 2; ++b)
#pragma unroll
                for (int m = 0; m < 4; ++m)
#pragma unroll
                    for (int n = 0; n < 2; ++n) acc[a][b][m][n] = (f32x4){0.f, 0.f, 0.f, 0.f};
        cur = nxt; cA = nA; cB = nB; ++ui;
        if constexpr (ALIGN_EPI) { if (wr == 1) PG8_BAR; }
    }
    PG8_WAIT_V(0);
    if constexpr (!ALIGN_EPI) { if (wr == 0) PG8_BAR; }
    PG8_BAR;
    if constexpr (Epi::AFTER_DRAIN) { E.fused(acc, cur, wr, wc, fr, fq, lds, wid, lane); S.done(cur); }
#undef PG8_SA
#undef PG8_SB
#undef PG8_STAGE
#undef PG8_LDA
#undef PG8_LDB
#undef PG8_MMA
#undef PG8_WAIT_V
#undef PG8_WAIT_L
#undef PG8_BAR
#undef PG8_SCHED
}
}
constexpr int NWAVES = 8;
constexpr int DM = 1024, NB_P = 8, TSEQ = 2048, NB_S = 128, NB_TOT = NB_P + NB_S;
constexpr int MP = NB_P * TSEQ;
constexpr int MR = MP + NB_S;
constexpr int MPAD = 16640;
constexpr int DFF = 2816, NPAGES = 16, PAGE = 128, NPHYS = 2560;
constexpr float NORM_EPS = 1e-6f;
constexpr float LOG2E = 1.4426950408889634f;
enum { I_XP = 0, I_XS, I_CP, I_CS, I_CK, I_CV, I_SPOOL, I_SRET, I_PT, I_WADA, I_BADA, I_NPRE, I_NPOST, I_FIN, I_FOUT, I_WIE, I_SBB, I_PW, I_PS, I_WOE, I_WIO, I_WOO, N_IN };
constexpr size_t O_Y = 0, O_KP = 16908288, O_VP = 25296896, O_POOLP = 33685504, O_RETP = 33746944, O_KS = 37941248, O_VS = 38006784, O_POOLS = 38072320, O_RETS = 39055360, O_END = 106164224;

constexpr size_t MiB = 1u << 20;
constexpr size_t al(size_t x) { return (x + 4095) & ~(size_t)4095; }
constexpr size_t WS_CTL = 0, CTL_ZERO_BYTES = 1 * MiB;
constexpr size_t WS_WADA = 2 * MiB;
constexpr size_t WS_WFIN = WS_WADA + al((size_t)18432 * 1024 * 2);
constexpr size_t WFIN_SZ = (size_t)5632 * 1024 * 2;
constexpr size_t WS_WFOUT = WS_WFIN + 4 * WFIN_SZ;
constexpr size_t WFOUT_SZ = (size_t)1024 * 2816 * 2;
constexpr size_t WS_WEI = WS_WFOUT + 4 * WFOUT_SZ;
constexpr size_t WS_WEO = WS_WEI + (size_t)2048 * 1024 * 2;
constexpr size_t WS_WPOOL = WS_WEO + (size_t)1024 * 1024 * 2;
constexpr size_t WS_WOI = WS_WPOOL + (size_t)512 * 512 * 2;
constexpr size_t WS_WOO = WS_WOI + (size_t)6144 * 1024 * 2;
constexpr size_t WS_COND = WS_WOO + (size_t)1024 * 2048 * 2;
constexpr size_t WS_MODT = WS_COND + (size_t)256 * 1024 * 2;
constexpr size_t WS_H = al(WS_MODT + (size_t)NB_TOT * 18432 * 4);
constexpr size_t WS_G = WS_H + (size_t)MPAD * 1024 * 2;
constexpr size_t WS_Y = WS_G + (size_t)MPAD * 2816 * 2;
constexpr size_t WS_Q = WS_Y + (size_t)MPAD * 1024 * 4;
constexpr size_t WS_KB = WS_Q + (size_t)MPAD * 512 * 2;
constexpr size_t WS_VB = WS_KB + (size_t)MPAD * 512 * 2;
constexpr size_t WS_U = WS_VB + (size_t)MPAD * 512 * 2;
constexpr size_t WS_D = WS_U + (size_t)MPAD * 512 * 4;
constexpr size_t WS_O = WS_D + (size_t)MPAD * 512 * 2;
constexpr size_t WS_RQ = WS_O + (size_t)MPAD * 1024 * 2;
constexpr size_t WS_RK = WS_RQ + (size_t)MPAD * 1024 * 2;
constexpr size_t WS_RV = WS_RK + (size_t)MPAD * 1024 * 2;
constexpr size_t WS_RG = WS_RV + (size_t)MPAD * 2048 * 2;
constexpr size_t WS_RO = WS_RG + (size_t)MPAD * 2048 * 2;
constexpr size_t WS_SBP = WS_RO + (size_t)MPAD * 2048 * 2;
constexpr size_t WS_YS = al(WS_SBP + (size_t)128 * 16 * 8 * 80 * 4);
constexpr size_t WS_END = al(WS_YS + (size_t)11 * 128 * 1024 * 4);
constexpr int CW_TMO = 0, CW_CODE = 1;
constexpr int CW_BAR = 4096;

constexpr int RING_OFF = 0, RING_BYTES = 155648;
constexpr int LDSCTL_OFF = RING_BYTES, MISC_OFF = LDSCTL_OFF + 320;
constexpr int LDS_BYTES = 156672;
static_assert(MISC_OFF + 128 <= LDS_BYTES, "LDS map");

#define GAS __attribute__((address_space(1)))
#define LAS __attribute__((address_space(3)))
typedef unsigned short bf16;
typedef unsigned v4u __attribute__((ext_vector_type(4)));
typedef unsigned v2u __attribute__((ext_vector_type(2)));
typedef float f32x4 __attribute__((ext_vector_type(4)));
typedef float f32x16 __attribute__((ext_vector_type(16)));
typedef short bf16x8 __attribute__((ext_vector_type(8)));
typedef short s16x4 __attribute__((ext_vector_type(4)));
typedef GAS unsigned gu32;
#define RLX_AGENT __ATOMIC_RELAXED, __HIP_MEMORY_SCOPE_AGENT
#define LDS_WAIT() asm volatile("s_waitcnt lgkmcnt(0)" ::: "memory")
#define VM_WAIT() asm volatile("s_waitcnt vmcnt(0)" ::: "memory")
__device__ __forceinline__ unsigned f2bf(float f) { unsigned u = __builtin_bit_cast(unsigned, f); return (u + 0x7fffu + ((u >> 16) & 1u)) >> 16; }
__device__ __forceinline__ unsigned pk2(float lo, float hi) { return f2bf(lo) | (f2bf(hi) << 16); }
__device__ __forceinline__ float bf2f(unsigned short h) { return __builtin_bit_cast(float, (unsigned)h << 16); }
__device__ __forceinline__ float bflo(unsigned w) { return __builtin_bit_cast(float, w << 16); }
__device__ __forceinline__ float bfhi(unsigned w) { return __builtin_bit_cast(float, w & 0xffff0000u); }
__device__ __forceinline__ float wave_sum(float v) {
#pragma unroll
    for (int o = 1; o < 64; o <<= 1) v += __shfl_xor(v, o);
    return v;
}
#define XB_TMO      128
#define XB_XCNT(j)  (256  + 64 * (j))
#define XB_XSUB(j)  (1280 + 64 * (j))
#define XB_XGEN(j)  (2304 + 64 * (j))
#define XB_TOP      3328
#define XB_TOPGEN   3392
#define XCD_BAR_WORDS 3456
#define XB_SPIN_CAP (1u << 18)

__device__ __forceinline__ unsigned xb_ld(unsigned* p)              { return __hip_atomic_load(p, __ATOMIC_RELAXED, __HIP_MEMORY_SCOPE_AGENT); }
__device__ __forceinline__ unsigned xb_add(unsigned* p, unsigned v) { return __hip_atomic_fetch_add(p, v, __ATOMIC_RELAXED, __HIP_MEMORY_SCOPE_AGENT); }
__device__ __forceinline__ unsigned xb_xcc_id() { return (unsigned)__builtin_amdgcn_s_getreg((3 << 11) | 20) & 0xFu; }
#define XB_SPIN(cond, bar) do { unsigned _sp = 0; while (cond) { __builtin_amdgcn_s_sleep(1); \
    if ((++_sp & 255u) == 0u) { if (xb_ld(&(bar)[XB_TMO])) break; if (_sp > XB_SPIN_CAP) { atomicAdd(&(bar)[XB_TMO], 1u); break; } } } } while (0)

struct XcdBarrier {
    unsigned* bar; unsigned x;
    volatile LAS unsigned* st;
};

__device__ __forceinline__ XcdBarrier xcd_barrier_post(unsigned* bar, volatile LAS unsigned* st, int xb_tid) {
    XcdBarrier b; b.bar = bar; b.x = xb_xcc_id(); b.st = st;
    if (xb_tid == 0) (void)xb_add(&bar[XB_XCNT(b.x)], 1u);
    return b;
}
__device__ __forceinline__ void xcd_barrier_complete(unsigned* bar, unsigned x, unsigned& nloc, unsigned& nx) {
    const unsigned G = gridDim.x * gridDim.y * gridDim.z;
    unsigned sum, cnt, mine, sp = 0u;
    for (;;) {
        sum = 0u; cnt = 0u; mine = 0u;
#pragma unroll
        for (unsigned j = 0; j < 16; ++j) { const unsigned c = xb_ld(&bar[XB_XCNT(j)]); sum += c; cnt += (c > 0u) ? 1u : 0u; mine = (j == x) ? c : mine; }
        if (sum == G) break;
        __builtin_amdgcn_s_sleep(1);
        if ((++sp & 255u) == 0u) { if (xb_ld(&bar[XB_TMO])) break; if (sp > XB_SPIN_CAP) { atomicAdd(&bar[XB_TMO], 1u); break; } }
    }
    nloc = mine > 0u ? mine : 1u; nx = cnt > 0u ? cnt : 1u;
}

__device__ __forceinline__ void xcd_barrier(const XcdBarrier& b, int xb_tid) {
    asm volatile("s_waitcnt vmcnt(0)" ::: "memory");
    __syncthreads();
    if (xb_tid == 0) {
        unsigned* bar = b.bar;
        __builtin_amdgcn_s_waitcnt(0);
        unsigned nloc = b.st[0], nx = b.st[1];
        if (nloc == 0u) { xcd_barrier_complete(bar, b.x, nloc, nx); b.st[0] = nloc; b.st[1] = nx; }
        const unsigned old = xb_add(&bar[XB_XSUB(b.x)], 1u);
        const unsigned gen = old / nloc;
        if (old + 1u == (gen + 1u) * nloc) {
            __builtin_amdgcn_fence(__ATOMIC_RELEASE, "agent");
            asm volatile("s_waitcnt vmcnt(0)" ::: "memory");
            const unsigned og = xb_add(&bar[XB_TOP], 1u);
            const unsigned tg = og / nx;
            if (og + 1u == (tg + 1u) * nx) xb_add(&bar[XB_TOPGEN], 1u);
            else XB_SPIN(xb_ld(&bar[XB_TOPGEN]) == tg, bar);
            __builtin_amdgcn_fence(__ATOMIC_ACQUIRE, "agent");
            xb_add(&bar[XB_XGEN(b.x)], 1u);
            asm volatile("s_waitcnt vmcnt(0)" ::: "memory");
        } else {
            XB_SPIN(xb_ld(&bar[XB_XGEN(b.x)]) == gen, bar);
            __builtin_amdgcn_fence(__ATOMIC_ACQUIRE, "agent");
            asm volatile("s_waitcnt vmcnt(0)" ::: "memory");
        }
    }
    __syncthreads();
}
struct Frame {
    LAS unsigned char* lds;
    volatile LAS unsigned* MISC;
    gu32* ctl;
    int tid, lane, wave;
    int G;
    float* out;
    unsigned char* ws;
};
struct Args { const float* in[N_IN]; float* out; unsigned char* ws; int ph_lo, ph_hi; };
#define KARG ((const __attribute__((address_space(4))) Args*)__builtin_amdgcn_kernarg_segment_ptr())
#define INP(i) (KARG->in[i])
#define WSP(T, off) ((T*)(F.ws + (off)))

constexpr int TR_PITCH = 68, TR_WAVE_BYTES = 64 * TR_PITCH * 4;
static_assert(8 * TR_WAVE_BYTES <= RING_BYTES, "transposer LDS map");
__device__ __forceinline__ void tr_item(const float* Wblk, int ldw, bf16* WTblk, int ldwt, LAS float* scr, int lane, bool zero) {
    f32x4 v[16];
    const int r = lane >> 4, c4 = lane & 15;
#pragma unroll
    for (int i = 0; i < 16; ++i) v[i] = zero ? (f32x4){0.f, 0.f, 0.f, 0.f} : *(const GAS f32x4*)(Wblk + (size_t)(4 * i + r) * ldw + 4 * c4);
#pragma unroll
    for (int i = 0; i < 16; ++i) *(LAS f32x4*)(scr + (4 * i + r) * TR_PITCH + 4 * c4) = v[i];
    LDS_WAIT(); asm volatile("" ::: "memory");
    const int c = lane & 7;
#pragma unroll
    for (int j = 0; j < 8; ++j) { const int n = (lane >> 3) + 8 * j; const LAS float* s = scr + (8 * c) * TR_PITCH + n;
        v4u o; o.x = pk2(s[0 * TR_PITCH], s[1 * TR_PITCH]); o.y = pk2(s[2 * TR_PITCH], s[3 * TR_PITCH]); o.z = pk2(s[4 * TR_PITCH], s[5 * TR_PITCH]); o.w = pk2(s[6 * TR_PITCH], s[7 * TR_PITCH]);
        *(GAS v4u*)(WTblk + (size_t)n * ldwt + 8 * c) = o; }
    LDS_WAIT(); asm volatile("" ::: "memory");
}
__device__ __forceinline__ void tr_plain(const float* W, int K, int N, bf16* WT, LAS float* scr, int item, int lane) {
    const int nblk = N / 64, kb = item / nblk, nb = item - kb * nblk;
    tr_item(W + (size_t)(64 * kb) * N + 64 * nb, N, WT + (size_t)(64 * nb) * K + 64 * kb, K, scr, lane, false);
}
__device__ __forceinline__ void conv_ffn_item(Frame& F, int lf, int r, LAS float* scr) {
    constexpr int IT_FIN = 16 * 88;
    if (r < IT_FIN) {
        const int kb = r / 88, nb = r - kb * 88, n0 = 64 * nb; const int up = n0 >= DFF, j0 = up ? n0 - DFF : n0; const int row0 = 256 * (j0 >> 7) + 128 * up + (j0 & 127);
        tr_item(INP(I_FIN) + (size_t)lf * 1024 * 5632 + (size_t)(64 * kb) * 5632 + n0, 5632, WSP(bf16, WS_WFIN + lf * WFIN_SZ) + (size_t)row0 * 1024 + 64 * kb, 1024, scr, F.lane, false);
    } else tr_plain(INP(I_FOUT) + (size_t)lf * 2816 * 1024, 2816, 1024, WSP(bf16, WS_WFOUT + lf * WFOUT_SZ), scr, r - IT_FIN, F.lane);
}
__device__ __forceinline__ void conv_set(Frame& F, int set, int rank, int nw) {
    LAS float* scr = (LAS float*)(F.lds + RING_OFF + F.wave * TR_WAVE_BYTES);
    constexpr int IT_FFN = 16 * 88 + 44 * 16, IT_EI = 16 * 32, IT_EO = 16 * 16, IT_OI = 16 * 96, IT_OO = 32 * 16, IT_PW = 8 * 8;
    if (set == 0) {
        constexpr int NITEMS = IT_FFN + IT_EI + IT_EO + IT_PW;
        for (int it = rank; it < NITEMS; it += nw) {
            int r = it;
            if (r < IT_FFN) { conv_ffn_item(F, 0, r, scr); continue; } r -= IT_FFN;
            if (r < IT_EI) { tr_plain(INP(I_WIE), 1024, 2048, WSP(bf16, WS_WEI), scr, r, F.lane); continue; } r -= IT_EI;
            if (r < IT_EO) { tr_plain(INP(I_WOE), 1024, 1024, WSP(bf16, WS_WEO), scr, r, F.lane); continue; } r -= IT_EO;
            {
                const int kb = r / 8, nb = r - kb * 8, k0 = 64 * kb, n0 = 64 * nb, gk = k0 >> 7, gn = n0 >> 7;
                tr_item(INP(I_PW) + (size_t)gk * 16384 + (size_t)(k0 & 127) * 128 + (n0 & 127), 128, WSP(bf16, WS_WPOOL) + (size_t)n0 * 512 + k0, 512, scr, F.lane, gk != gn); }
        }
    } else if (set <= 3) {
        for (int it = rank; it < IT_FFN; it += nw) conv_ffn_item(F, set, it, scr);
    } else {
        for (int it = rank; it < IT_OI + IT_OO; it += nw) {
            if (it < IT_OI) tr_plain(INP(I_WIO), 1024, 6144, WSP(bf16, WS_WOI), scr, it, F.lane);
            else tr_plain(INP(I_WOO), 2048, 1024, WSP(bf16, WS_WOO), scr, it - IT_OI, F.lane);
        }
    }
}
__device__ __forceinline__ void conv_in_tail(Frame& F, int set, int total_units) {
    const int used = total_units % F.G, c = (int)blockIdx.x;
    if (used != 0 && c >= used) conv_set(F, set, (c - used) * NWAVES + F.wave, (F.G - used) * NWAVES);
}

__device__ __forceinline__ f32x4 ldy(const bf16* yrow, int lane, int j) {
    const v2u w = *((const GAS v2u*)yrow + lane + 64 * j); return (f32x4){bflo(w.x), bfhi(w.x), bflo(w.y), bfhi(w.y)}; }
__device__ __forceinline__ void seam_row(bool has_y, bool has_h, f32x4 (&x)[4], const f32x4 (&y)[4], const f32x4 (&gt)[4], const f32x4 (&sh)[4], const f32x4 (&sc)[4], float* Xrow, bf16* Hrow, int lane) {
    if (has_y) {
        float s = 0.f;
#pragma unroll
        for (int j = 0; j < 4; ++j) s += (y[j].x * y[j].x + y[j].y * y[j].y) + (y[j].z * y[j].z + y[j].w * y[j].w);
        const float rs = 1.0f / sqrtf(wave_sum(s) * (1.0f / 1024.0f) + NORM_EPS);
#pragma unroll
        for (int j = 0; j < 4; ++j) { x[j] = x[j] + gt[j] * y[j] * rs; *((GAS f32x4*)Xrow + lane + 64 * j) = x[j]; }
    }
    if (has_h) {
        float s = 0.f;
#pragma unroll
        for (int j = 0; j < 4; ++j) s += (x[j].x * x[j].x + x[j].y * x[j].y) + (x[j].z * x[j].z + x[j].w * x[j].w);
        const float rs = 1.0f / sqrtf(wave_sum(s) * (1.0f / 1024.0f) + NORM_EPS);
        GAS unsigned long long* o8 = (GAS unsigned long long*)Hrow + lane;
#pragma unroll
        for (int j = 0; j < 4; ++j) { const f32x4 h = x[j] * rs * sc[j] + sh[j];
            o8[64 * j] = (unsigned long long)pk2(h.x, h.y) | ((unsigned long long)pk2(h.z, h.w) << 32); }
    }
}
__device__ __forceinline__ void seam_phase(Frame& F, bool first, bool has_y, bool has_h, int gate_off, int pre_off, int ks) {
    const int gw = blockIdx.x * NWAVES + F.wave, NGW = F.G * NWAVES, lane = F.lane;
    const float* MT = WSP(const float, WS_MODT); const bf16* Y = WSP(const bf16, WS_Y); bf16* H = WSP(bf16, WS_H); float* X = F.out + O_Y;
    f32x4 gt[4], sh[4], sc[4], x[4], y[4], xn[4], yn[4];
#pragma unroll
    for (int j = 0; j < 4; ++j) { gt[j] = (f32x4){0.f, 0.f, 0.f, 0.f}; sh[j] = gt[j]; sc[j] = gt[j]; y[j] = gt[j]; yn[j] = gt[j]; }
    { const int per = (MP + NGW - 1) / NGW, r0 = gw * per, r1 = (r0 + per < MP) ? r0 + per : MP;
      const float* xsrc = first ? INP(I_XP) : X;
      int bcur = -1;
      if (r0 < r1) {
#pragma unroll
          for (int j = 0; j < 4; ++j) { x[j] = *((const GAS f32x4*)(xsrc + (size_t)r0 * 1024) + lane + 64 * j); if (has_y) y[j] = ldy(Y + (size_t)r0 * 1024, lane, j); } }
      for (int r = r0; r < r1; ++r) {
          const int b = r >> 11;
          if (b != bcur) { bcur = b; const float* T = MT + (size_t)b * 18432;
#pragma unroll
              for (int j = 0; j < 4; ++j) { if (has_y) gt[j] = *((const GAS f32x4*)(T + gate_off + 2048) + lane + 64 * j);
                  if (has_h) { sh[j] = *((const GAS f32x4*)(T + pre_off) + lane + 64 * j); sc[j] = *((const GAS f32x4*)(T + pre_off + 1024) + lane + 64 * j); } } }
          if (r + 1 < r1) {
#pragma unroll
              for (int j = 0; j < 4; ++j) { xn[j] = *((const GAS f32x4*)(xsrc + (size_t)(r + 1) * 1024) + lane + 64 * j); if (has_y) yn[j] = ldy(Y + (size_t)(r + 1) * 1024, lane, j); } }
          seam_row(has_y, has_h, x, y, gt, sh, sc, X + (size_t)r * 1024, H + (size_t)r * 1024, lane);
#pragma unroll
          for (int j = 0; j < 4; ++j) { x[j] = xn[j]; y[j] = yn[j]; }
      } }
    for (int rs_ = NGW - 1 - gw; rs_ < NB_S; rs_ += NGW) {
        const int r = MP + rs_; const float* T = MT + (size_t)(NB_P + rs_) * 18432;
        const float* xrow = first ? INP(I_XS) + (size_t)rs_ * 1024 : X + (size_t)r * 1024; const float* ys = WSP(const float, WS_YS) + (size_t)rs_ * 1024;
#pragma unroll
        for (int j = 0; j < 4; ++j) { x[j] = *((const GAS f32x4*)xrow + lane + 64 * j);
            if (has_y) { y[j] = *((const GAS f32x4*)ys + lane + 64 * j); gt[j] = *((const GAS f32x4*)(T + gate_off + 2048) + lane + 64 * j); }
            if (has_h) { sh[j] = *((const GAS f32x4*)(T + pre_off) + lane + 64 * j); sc[j] = *((const GAS f32x4*)(T + pre_off + 1024) + lane + 64 * j); } }
        if (has_y) for (int q = 1; q < ks; ++q)
#pragma unroll
            for (int j = 0; j < 4; ++j) y[j] = y[j] + *((const GAS f32x4*)(ys + (size_t)q * NB_S * 1024) + lane + 64 * j);
        seam_row(has_y, has_h, x, y, gt, sh, sc, X + (size_t)r * 1024, H + (size_t)r * 1024, lane);
    }
}
#define MFMA32(a, b, c) __builtin_amdgcn_mfma_f32_32x32x16_bf16((a), (b), (c), 0, 0, 0)
typedef float f32x2 __attribute__((ext_vector_type(2)));
typedef __bf16 bf16v2 __attribute__((ext_vector_type(2)));
__device__ __forceinline__ unsigned pkbf(float a, float b) { f32x2 v = {a, b}; bf16v2 r = __builtin_convertvector(v, bf16v2); return __builtin_bit_cast(unsigned, r); }
__device__ __forceinline__ bf16x8 pack8(float a0, float a1, float a2, float a3, float a4, float a5, float a6, float a7) {
    v4u p; p.x = pkbf(a0, a1); p.y = pkbf(a2, a3); p.z = pkbf(a4, a5); p.w = pkbf(a6, a7); return __builtin_bit_cast(bf16x8, p); }
__device__ __forceinline__ int crow(int i, int hb) { return (i & 3) + 8 * (i >> 2) + 4 * hb; }
__device__ __forceinline__ s16x4 tr_read(const LAS unsigned char* p) { return __builtin_amdgcn_ds_read_tr16_b64_v4i16((LAS s16x4*)p); }
__device__ __forceinline__ bf16x8 tr_pair(const LAS unsigned char* lo, const LAS unsigned char* hi) { const s16x4 a = tr_read(lo), b = tr_read(hi); return __builtin_shufflevector(a, b, 0, 1, 2, 3, 4, 5, 6, 7); }
__device__ __forceinline__ float partner32(float x, int hb) {
    const unsigned u = __builtin_bit_cast(unsigned, x);
    auto r = __builtin_amdgcn_permlane32_swap(u, u, false, false);
    return __builtin_bit_cast(float, hb ? r[0] : r[1]);
}
template <class T> __device__ __forceinline__ T gld(const void* ubase, unsigned voff) { return *(const GAS T*)((const GAS char*)ubase + voff); }
template <class T> __device__ __forceinline__ void gst(void* ubase, unsigned voff, T v) { *(GAS T*)((GAS char*)ubase + voff) = v; }
#define WG_BAR() do { asm volatile("s_waitcnt lgkmcnt(0)" ::: "memory"); __builtin_amdgcn_s_barrier(); asm volatile("" ::: "memory"); } while (0)

constexpr int SB_PITCH = 144;
constexpr int SB_TILE = 64 * SB_PITCH;
template <bool DIAG>
__device__ __forceinline__ void sb_subtile(const LAS unsigned char* Kt, const LAS unsigned char* Vt, int sub, const bf16x8 (&qf)[4], float biasl2, float& C, f32x16 (&o)[2], int lane) {
    const int r32 = lane & 31, hb = lane >> 5;
    f32x16 acc;
#pragma unroll
    for (int i = 0; i < 16; ++i) acc[i] = biasl2;
#pragma unroll
    for (int c = 0; c < 4; ++c) { const bf16x8 kf = *(const LAS bf16x8*)(Kt + (32 * sub + r32) * SB_PITCH + 32 * c + 16 * hb); acc = MFMA32(kf, qf[c], acc); }
    float r[16], be[16];
#pragma unroll
    for (int i = 0; i < 16; ++i) { const float e = __builtin_amdgcn_exp2f(__builtin_fminf(acc[i], 100.0f)); r[i] = __builtin_amdgcn_rcpf(1.0f + e); be[i] = e * r[i];
        if (DIAG) { if (crow(i, hb) >= r32) { r[i] = 1.0f; be[i] = 0.0f; } } }
    float sfx[16], T[4], Tp[4];
#pragma unroll
    for (int g = 0; g < 4; ++g) { const float a0 = r[4 * g], a1 = r[4 * g + 1], a2 = r[4 * g + 2], a3 = r[4 * g + 3];
        sfx[4 * g + 3] = 1.0f; sfx[4 * g + 2] = a3; const float s1 = a2 * a3; sfx[4 * g + 1] = s1; const float s0 = a1 * s1; sfx[4 * g] = s0; T[g] = a0 * s0; Tp[g] = partner32(T[g], hb); }
    const float p3 = T[3] * Tp[3], p2 = T[2] * Tp[2], p1 = T[1] * Tp[1], p0 = T[0] * Tp[0];
    float suf[4]; suf[3] = 1.0f; suf[2] = p3; suf[1] = p2 * p3; suf[0] = p1 * suf[1]; const float tot = p0 * suf[0];
    float w[16];
#pragma unroll
    for (int g = 0; g < 4; ++g) { const float off = C * suf[g] * (hb == 0 ? Tp[g] : 1.0f);
#pragma unroll
        for (int e = 0; e < 4; ++e) w[4 * g + e] = be[4 * g + e] * sfx[4 * g + e] * off; }
    C *= tot;
    const int q4 = (lane & 15) >> 2, p4 = lane & 3, blk = (lane >> 4) & 1;
#pragma unroll
    for (int s = 0; s < 2; ++s) { const bf16x8 xs = pack8(w[8 * s], w[8 * s + 1], w[8 * s + 2], w[8 * s + 3], w[8 * s + 4], w[8 * s + 5], w[8 * s + 6], w[8 * s + 7]);
#pragma unroll
        for (int dh = 0; dh < 2; ++dh) { const LAS unsigned char* a = Vt + (32 * sub + 16 * s + 4 * hb + q4) * SB_PITCH + (32 * dh + 16 * blk) * 2 + 8 * p4;
            const bf16x8 pb = tr_pair(a, a + 8 * SB_PITCH); o[dh] = MFMA32(xs, pb, o[dh]); } }
}
constexpr int SBW_BUF = 2 * 32 * SB_PITCH;
constexpr int SBW_WAVE = 2 * SBW_BUF;
static_assert(8 * SBW_WAVE <= RING_BYTES, "attention LDS map");
__device__ __forceinline__ void sb_prompt_item(Frame& F, int bh, int qt) {
#ifdef STUB_SBP
    return;
#endif
    const int b = bh >> 3, h = bh & 7, lane = F.lane, r32 = lane & 31, hb = lane >> 5;
    const bf16* Q = WSP(const bf16, WS_Q); const bf16* Kb = WSP(const bf16, WS_KB); const bf16* Vb = WSP(const bf16, WS_VB); bf16* O = WSP(bf16, WS_O);
    const size_t rowb = (size_t)b * TSEQ;
    bf16x8 qf[4];
    { const bf16* qub = Q + (rowb + 32 * qt) * 512 + h * 64; const unsigned qoff = (unsigned)(r32 * 512 + 8 * hb) * 2u;
#pragma unroll
      for (int c = 0; c < 4; ++c) qf[c] = gld<bf16x8>(qub + 16 * c, qoff); }
    const float biasl2 = INP(I_SBB)[h] * LOG2E;
    f32x16 o[2];
#pragma unroll
    for (int i = 0; i < 16; ++i) { o[0][i] = 0.f; o[1][i] = 0.f; }
    float C = 1.0f;
    const int kr = lane >> 3, pc = lane & 7;
    const bf16* kub = Kb + rowb * 512 + h * 64; const bf16* vub = Vb + rowb * 512 + h * 64; const unsigned kvoff = (unsigned)(kr * 512 + pc * 8) * 2u;
    v4u kreg[4], vreg[4];
#pragma unroll
    for (int i = 0; i < 4; ++i) { kreg[i] = gld<v4u>(kub + (size_t)(32 * qt + 8 * i) * 512, kvoff); vreg[i] = gld<v4u>(vub + (size_t)(32 * qt + 8 * i) * 512, kvoff); }
    LAS unsigned char* wb = F.lds + RING_OFF + F.wave * SBW_WAVE;
    for (int s = qt; s >= 0; --s) {
        LAS unsigned char* Kt = wb + (s & 1) * SBW_BUF; LAS unsigned char* Vt = Kt + 32 * SB_PITCH;
#pragma unroll
        for (int i = 0; i < 4; ++i) { *(LAS v4u*)(Kt + (8 * i + kr) * SB_PITCH + pc * 16) = kreg[i]; *(LAS v4u*)(Vt + (8 * i + kr) * SB_PITCH + pc * 16) = vreg[i]; }
        if (s > 0) {
#pragma unroll
            for (int i = 0; i < 4; ++i) { kreg[i] = gld<v4u>(kub + (size_t)(32 * (s - 1) + 8 * i) * 512, kvoff); vreg[i] = gld<v4u>(vub + (size_t)(32 * (s - 1) + 8 * i) * 512, kvoff); } }
        if (s == qt) sb_subtile<true>(Kt, Vt, 0, qf, biasl2, C, o, lane); else sb_subtile<false>(Kt, Vt, 0, qf, biasl2, C, o, lane);
    }
    bf16* oub = O + (rowb + 32 * qt) * 1024 + h * 64; const unsigned ooff = (unsigned)(4 * hb * 1024 + r32) * 2u;
#pragma unroll
    for (int dh = 0; dh < 2; ++dh)
#pragma unroll
        for (int i = 0; i < 16; ++i) gst<bf16>(oub + (size_t)crow(i, 0) * 1024 + 32 * dh, ooff, (bf16)f2bf(o[dh][i]));
}

template <int CTRL> __device__ __forceinline__ float dpp_f(float x) { return __builtin_bit_cast(float, __builtin_amdgcn_update_dpp(0, __builtin_bit_cast(int, x), CTRL, 0xf, 0xf, true)); }
__device__ __forceinline__ float row16_sum(float x) {
    x += dpp_f<0xB1>(x); x += dpp_f<0x4E>(x); x += dpp_f<0x141>(x); x += dpp_f<0x140>(x); return x; }
constexpr int SBS_STRIDE = 80;
__device__ __forceinline__ void sb_sample_item(Frame& F, int b, int pg) {
#ifdef STUB_SBS
    return;
#endif
    const int lane = F.lane, d4 = lane & 15, hl = lane >> 4;
    const float* ck = INP(I_CK); const float* cv = INP(I_CV); const int* pt = (const int*)INP(I_PT);
    const bf16* Q = WSP(const bf16, WS_Q);
    f32x4 qv[2]; float bias2[2];
#pragma unroll
    for (int hh = 0; hh < 2; ++hh) { const v2u qraw = *(const GAS v2u*)(Q + (size_t)(MP + b) * 512 + hh * 256 + 4 * lane);
        qv[hh] = (f32x4){bflo(qraw.x), bfhi(qraw.x), bflo(qraw.y), bfhi(qraw.y)}; bias2[hh] = INP(I_SBB)[4 * hh + hl] * LOG2E; }
    f32x4 oacc[2] = {(f32x4){0.f, 0.f, 0.f, 0.f}, (f32x4){0.f, 0.f, 0.f, 0.f}}; float C[2] = {1.0f, 1.0f};
    const int phys = __builtin_amdgcn_readfirstlane(pt[b * NPAGES + pg]);
    const float* kp = ck + (size_t)phys * (PAGE * 512); const float* vp = cv + (size_t)phys * (PAGE * 512);
    const unsigned loff = (unsigned)lane * 16u;
    f32x4 ka[8], va[8], kb[8], vb[8];
#define SBS_LOAD(KK, VV, t) do { _Pragma("unroll") for (int u = 0; u < 4; ++u) { const int pos_ = 127 - 4 * (t) - u; _Pragma("unroll") for (int hh = 0; hh < 2; ++hh) { \
        KK[2 * u + hh] = __builtin_nontemporal_load((const GAS f32x4*)((const GAS char*)(kp + (size_t)pos_ * 512 + hh * 256) + loff)); \
        VV[2 * u + hh] = __builtin_nontemporal_load((const GAS f32x4*)((const GAS char*)(vp + (size_t)pos_ * 512 + hh * 256) + loff)); } } } while (0)
#define SBS_COMP(KK, VV) do { _Pragma("unroll") for (int u = 0; u < 4; ++u) _Pragma("unroll") for (int hh = 0; hh < 2; ++hh) { const f32x4 kv = KK[2 * u + hh]; \
        float z = (kv.x * qv[hh].x + kv.y * qv[hh].y) + (kv.z * qv[hh].z + kv.w * qv[hh].w); z = row16_sum(z); \
        const float e = __builtin_amdgcn_exp2f(__builtin_fminf(z + bias2[hh], 100.0f)), r = __builtin_amdgcn_rcpf(1.0f + e); \
        const float wgt = e * r * C[hh]; C[hh] *= r; oacc[hh] = oacc[hh] + VV[2 * u + hh] * wgt; } } while (0)
    SBS_LOAD(ka, va, 0);
    for (int t = 0; t < 32; t += 2) {
        SBS_LOAD(kb, vb, t + 1);
        SBS_COMP(ka, va);
        if (t + 2 < 32) SBS_LOAD(ka, va, t + 2);
        SBS_COMP(kb, vb);
    }
#undef SBS_LOAD
#undef SBS_COMP
    float* P = WSP(float, WS_SBP) + (size_t)((b * NPAGES + pg) * 8) * SBS_STRIDE;
#pragma unroll
    for (int hh = 0; hh < 2; ++hh) { float* Ph = P + (4 * hh + hl) * SBS_STRIDE; *(GAS f32x4*)(Ph + 4 * d4) = oacc[hh]; if (d4 == 0) Ph[64] = C[hh]; }
}
__device__ __forceinline__ void even_post_phase(Frame& F) {
    const float* P = WSP(const float, WS_SBP); bf16* O = WSP(bf16, WS_O);
    for (int i = blockIdx.x * (NWAVES * 64) + F.tid; i < NB_S * 512; i += F.G * NWAVES * 64) {
        const int b = i >> 9, c = i & 511, h = c >> 6, d = c & 63;
        float acc = 0.f, carry = 1.0f;
        for (int pg = NPAGES - 1; pg >= 0; --pg) { const float* rec = P + (size_t)((b * NPAGES + pg) * 8 + h) * SBS_STRIDE; acc += carry * rec[d]; carry *= rec[64]; }
        O[(size_t)(MP + b) * 1024 + c] = (bf16)f2bf(acc);
    }
}
__device__ __forceinline__ void pool_d_rows(Frame& F) {
    const int gw = blockIdx.x * NWAVES + F.wave, NGW = F.G * NWAVES, lane = F.lane;
    const float* U = WSP(const float, WS_U); bf16* D = WSP(bf16, WS_D); const float* sp = INP(I_SPOOL);
    for (int ch = gw; ch < MP / 8; ch += NGW) {
        const int r0 = ch * 8, rb = r0 & ~(TSEQ - 1), t0 = r0 - rb;
        f32x4 A[11], Bq[23];
#pragma unroll
        for (int k = 0; k < 11; ++k) { int rr = r0 - 3 + k; rr = rr < rb ? rb : rr; A[k] = *(const GAS f32x4*)(U + (size_t)rr * 512 + 4 * lane); }
#pragma unroll
        for (int k = 0; k < 23; ++k) { int rr = r0 - 15 + k; rr = rr < rb ? rb : rr; Bq[k] = *(const GAS f32x4*)(U + (size_t)rr * 512 + 256 + 4 * lane); }
        const int w0 = 2 << (lane >> 5), w1 = 8 << (lane >> 5);
#pragma unroll
        for (int i = 0; i < 8; ++i) { const int t = t0 + i; const int c0 = (t + 1 < w0) ? t + 1 : w0, c1 = (t + 1 < w1) ? t + 1 : w1;
            f32x4 s0 = A[3 + i], s1 = Bq[15 + i];
#pragma unroll
            for (int j = 1; j < 4; ++j) { const f32x4 v = A[3 + i - j]; if (j < c0) s0 = s0 + v; }
#pragma unroll
            for (int j = 1; j < 16; ++j) { const f32x4 v = Bq[15 + i - j]; if (j < c1) s1 = s1 + v; }
            const f32x4 d0 = s0 * (1.0f / (float)c0) - A[3 + i], d1 = s1 * (1.0f / (float)c1) - Bq[15 + i];
            v2u o0, o1; o0.x = pkbf(d0.x, d0.y); o0.y = pkbf(d0.z, d0.w); o1.x = pkbf(d1.x, d1.y); o1.y = pkbf(d1.z, d1.w);
            *(GAS v2u*)(D + (size_t)(r0 + i) * 512 + 4 * lane) = o0; *(GAS v2u*)(D + (size_t)(r0 + i) * 512 + 256 + 4 * lane) = o1; }
    }
    for (int rs_ = NGW - 1 - gw; rs_ < NB_S; rs_ += NGW) {
        const int r = MP + rs_;
#pragma unroll
        for (int hf = 0; hf < 2; ++hf) {
            const int c = 256 * hf + 4 * lane, g = c >> 7, wdw = 2 << g;
            const f32x4 u0 = *(const GAS f32x4*)(U + (size_t)r * 512 + c);
            f32x4 s = u0;
            for (int j = 1; j < 16; ++j) if (j < wdw) s = s + *(const GAS f32x4*)(sp + ((size_t)rs_ * 15 + (15 - j)) * 512 + c);
            const f32x4 dv = s * (1.0f / (float)wdw) - u0;
            v2u o; o.x = pkbf(dv.x, dv.y); o.y = pkbf(dv.z, dv.w);
            *(GAS v2u*)(D + (size_t)r * 512 + c) = o;
        }
    }
}
__device__ __forceinline__ void pool_state_out(Frame& F) {
    const float* U = WSP(const float, WS_U); const float* sp = INP(I_SPOOL);
    const int gt = blockIdx.x * (NWAVES * 64) + F.tid, NT = F.G * NWAVES * 64;
    for (int i = gt; i < NB_P * 15 * 128; i += NT) { const int c4 = i & 127, j = (i >> 7) % 15, b = (i >> 7) / 15;
        *(GAS f32x4*)(F.out + O_POOLP + ((size_t)(b * 15 + j) * 512) + 4 * c4) = *(const GAS f32x4*)(U + ((size_t)b * TSEQ + TSEQ - 15 + j) * 512 + 4 * c4); }
    for (int i = gt; i < NB_S * 15 * 128; i += NT) { const int c4 = i & 127, j = (i >> 7) % 15, b = (i >> 7) / 15;
        const f32x4 v = (j < 14) ? *(const GAS f32x4*)(sp + ((size_t)b * 15 + j + 1) * 512 + 4 * c4) : *(const GAS f32x4*)(U + (size_t)(MP + b) * 512 + 4 * c4);
        *(GAS f32x4*)(F.out + O_POOLS + ((size_t)(b * 15 + j) * 512) + 4 * c4) = v; }
}
__device__ __forceinline__ int wq_next(Frame& F, int qword) {
    const unsigned v = __hip_atomic_fetch_add((unsigned*)(F.ctl + qword), F.lane == 0 ? 1u : 0u, __ATOMIC_RELAXED, __HIP_MEMORY_SCOPE_AGENT);
    return (int)__builtin_amdgcn_readfirstlane(v);
}
constexpr int CW_QATT = 8192, CW_QSMP = 8256;
__device__ __forceinline__ void even_mix_phase(Frame& F) {
    const bool streamer = true;
    if (streamer) for (;;) { const int i = wq_next(F, CW_QSMP); if (i >= NB_S * 16) break; sb_sample_item(F, i >> 4, 15 - (i & 15)); }
    for (;;) { const int i = wq_next(F, CW_QATT); if (i >= 4096) break;
        const int grp = i >> 3, bh = grp & 63, qb = 7 - (grp >> 6); sb_prompt_item(F, bh, 8 * qb + 7 - (i & 7)); }
#ifdef DUP_PROMPT
    for (;;) { const int i = wq_next(F, CW_QATT + 128); if (i >= 4096) break;
        const int grp = i >> 3, bh = grp & 63, qb = 7 - (grp >> 6); sb_prompt_item(F, bh, 8 * qb + 7 - (i & 7)); }
#endif
#ifdef DUP_SAMPLE
    for (;;) { const int i = wq_next(F, CW_QSMP + 128); if (i >= NB_S * 16) break; sb_sample_item(F, i >> 4, 15 - (i & 15)); }
#endif
    if (!streamer) for (;;) { const int i = wq_next(F, CW_QSMP); if (i >= NB_S * 16) break; sb_sample_item(F, i >> 4, 15 - (i & 15)); }
    pool_d_rows(F);
#ifdef DUP_POOL
    pool_d_rows(F);
#endif
    pool_state_out(F);
}

constexpr int RK_PITCH = 528, RV_PITCH = 144;
constexpr int R_KL = 0, R_VL = R_KL + 128 * RK_PITCH, R_VD = R_VL + 128 * RV_PITCH, R_SL = R_VD + 128 * RV_PITCH, R_END = R_SL + 256 * RV_PITCH;
static_assert(R_END <= RING_BYTES, "retention LDS map");
__device__ __forceinline__ void ret_prompt_unit(Frame& F, int b, int h, int sl) {
#ifdef STUB_RP
    return;
#endif
    const int w = F.wave, lane = F.lane, tid = F.tid, r32 = lane & 31, hb = lane >> 5;
    const int q4 = (lane & 15) >> 2, p4 = lane & 3, blk = (lane >> 4) & 1;
    const int lt = (w < 4) ? ((0x2130 >> (4 * w)) & 15) : 3 - ((0x2130 >> (4 * (w - 4))) & 15), eh = w >> 2;
    const float gam = 1.0f - __builtin_amdgcn_exp2f(-5.0f - (float)h), lg = __builtin_log2f(gam);
    const size_t row0 = (size_t)b * TSEQ;
    const bf16* Rq = WSP(const bf16, WS_RQ) + row0 * 1024 + h * 256; const bf16* Rk = WSP(const bf16, WS_RK) + row0 * 1024 + h * 256;
    const bf16* Rv = WSP(const bf16, WS_RV) + row0 * 2048 + h * 512 + sl * 64; bf16* Ro = WSP(bf16, WS_RO) + row0 * 2048 + h * 512 + sl * 64;
    LAS unsigned char* KL = F.lds + RING_OFF + R_KL; LAS unsigned char* VL = F.lds + RING_OFF + R_VL; LAS unsigned char* VD = F.lds + RING_OFF + R_VD; LAS unsigned char* SL = F.lds + RING_OFF + R_SL;
    f32x16 sacc[2];
#pragma unroll
    for (int i = 0; i < 16; ++i) { sacc[0][i] = 0.f; sacc[1][i] = 0.f; }
    const float g128 = __builtin_amdgcn_exp2f(128.0f * lg);
    v4u kreg[8], vreg[2]; bf16x8 qf[16];
    const unsigned koff = (unsigned)((tid >> 5) * 1024 + (tid & 31) * 8) * 2u, voff = (unsigned)((tid >> 3) * 2048 + (tid & 7) * 8) * 2u, qoff = (unsigned)(r32 * 1024 + 8 * hb) * 2u;
#pragma unroll
    for (int i = 0; i < 8; ++i) kreg[i] = gld<v4u>(Rk + (size_t)(16 * i) * 1024, koff);
#pragma unroll
    for (int i = 0; i < 2; ++i) vreg[i] = gld<v4u>(Rv + (size_t)(64 * i) * 2048, voff);
#pragma unroll
    for (int s = 0; s < 16; ++s) qf[s] = gld<bf16x8>(Rq + (size_t)(32 * lt) * 1024 + 16 * s, qoff);
    for (int c = 0; c < 16; ++c) {
        WG_BAR();
        float lgc = lg; asm volatile("" : "+v"(lgc));
#pragma unroll
        for (int i = 0; i < 8; ++i) { const int p = tid + 512 * i; *(LAS v4u*)(KL + (p >> 5) * RK_PITCH + (p & 31) * 16) = kreg[i]; }
#pragma unroll
        for (int i = 0; i < 2; ++i) { const int p = tid + 512 * i, row = p >> 3; *(LAS v4u*)(VL + row * RV_PITCH + (p & 7) * 16) = vreg[i];
            const float f = __builtin_amdgcn_exp2f(lgc * (float)(127 - row)); v4u d;
            d.x = pkbf(bflo(vreg[i].x) * f, bfhi(vreg[i].x) * f); d.y = pkbf(bflo(vreg[i].y) * f, bfhi(vreg[i].y) * f); d.z = pkbf(bflo(vreg[i].z) * f, bfhi(vreg[i].z) * f); d.w = pkbf(bflo(vreg[i].w) * f, bfhi(vreg[i].w) * f);
            *(LAS v4u*)(VD + row * RV_PITCH + (p & 7) * 16) = d; }
#pragma unroll
        for (int e2 = 0; e2 < 2; ++e2)
#pragma unroll
            for (int g = 0; g < 4; ++g) { v2u o; o.x = pkbf(sacc[e2][4 * g], sacc[e2][4 * g + 1]); o.y = pkbf(sacc[e2][4 * g + 2], sacc[e2][4 * g + 3]);
                *(LAS v2u*)(SL + (32 * w + r32) * RV_PITCH + (32 * e2 + 8 * g + 4 * hb) * 2) = o; }
        WG_BAR();
        if (c < 15) {
            const bf16* nk = Rk + (size_t)(c + 1) * 128 * 1024; const bf16* nv = Rv + (size_t)(c + 1) * 128 * 2048;
#pragma unroll
            for (int i = 0; i < 8; ++i) kreg[i] = gld<v4u>(nk + (size_t)(16 * i) * 1024, koff);
#pragma unroll
            for (int i = 0; i < 2; ++i) vreg[i] = gld<v4u>(nv + (size_t)(64 * i) * 2048, voff);
        }
        f32x16 acc;
#pragma unroll
        for (int i = 0; i < 16; ++i) acc[i] = 0.f;
        {
            const LAS unsigned char* a0 = SL + (8 * hb + q4) * RV_PITCH + (32 * eh + 16 * blk) * 2 + 8 * p4;
            bf16x8 fn = tr_pair(a0, a0 + 4 * RV_PITCH);
#pragma unroll
            for (int s = 0; s < 16; ++s) { const bf16x8 f = fn;
                if (s < 15) { const LAS unsigned char* a = a0 + (16 * (s + 1)) * RV_PITCH; fn = tr_pair(a, a + 4 * RV_PITCH); }
                __builtin_amdgcn_sched_barrier(0);
                acc = MFMA32(qf[s], f, acc);
                __builtin_amdgcn_sched_barrier(0); } }
#pragma unroll
        for (int i = 0; i < 16; ++i) acc[i] *= __builtin_amdgcn_exp2f(lgc * (float)(32 * lt + crow(i, hb) + 1));
        for (int mt = 0; mt <= lt; ++mt) {
            f32x16 x;
#pragma unroll
            for (int i = 0; i < 16; ++i) x[i] = 0.f;
            { const LAS unsigned char* k0 = KL + (32 * mt + r32) * RK_PITCH + (8 * hb) * 2;
              bf16x8 kn = *(const LAS bf16x8*)k0;
#pragma unroll
              for (int s = 0; s < 16; ++s) { const bf16x8 kf = kn;
                  if (s < 15) kn = *(const LAS bf16x8*)(k0 + 32 * (s + 1));
                  __builtin_amdgcn_sched_barrier(0);
                  x = MFMA32(kf, qf[s], x);
                  __builtin_amdgcn_sched_barrier(0); } }
            float val[16];
#pragma unroll
            for (int i = 0; i < 16; ++i) { const int diff = (32 * lt + r32) - (32 * mt + crow(i, hb)); val[i] = (diff >= 0) ? x[i] * __builtin_amdgcn_exp2f(lgc * (float)diff) : 0.f; }
#pragma unroll
            for (int s2 = 0; s2 < 2; ++s2) { const bf16x8 xs = pack8(val[8 * s2], val[8 * s2 + 1], val[8 * s2 + 2], val[8 * s2 + 3], val[8 * s2 + 4], val[8 * s2 + 5], val[8 * s2 + 6], val[8 * s2 + 7]);
                const LAS unsigned char* a = VL + (32 * mt + 16 * s2 + 4 * hb + q4) * RV_PITCH + (32 * eh + 16 * blk) * 2 + 8 * p4;
                acc = MFMA32(xs, tr_pair(a, a + 8 * RV_PITCH), acc); }
        }
        { bf16* oub = Ro + (size_t)(c * 128 + 32 * lt) * 2048 + 32 * eh; const unsigned ooff = (unsigned)(4 * hb * 2048 + r32) * 2u;
#pragma unroll
          for (int i = 0; i < 16; ++i) gst<bf16>(oub + (size_t)crow(i, 0) * 2048, ooff, (bf16)f2bf(acc[i])); }
        if (c < 15) {
#pragma unroll
            for (int s = 0; s < 16; ++s) qf[s] = gld<bf16x8>(Rq + (size_t)((c + 1) * 128 + 32 * lt) * 1024 + 16 * s, qoff);
        }
#pragma unroll
        for (int i = 0; i < 16; ++i) { sacc[0][i] *= g128; sacc[1][i] *= g128; }
        { const LAS unsigned char* kb0 = KL + (8 * hb + q4) * RK_PITCH + (32 * w + 16 * blk) * 2 + 8 * p4;
          const LAS unsigned char* va0 = VD + (8 * hb + q4) * RV_PITCH + (16 * blk) * 2 + 8 * p4;
          bf16x8 pbn = tr_pair(kb0, kb0 + 4 * RK_PITCH), van0 = tr_pair(va0, va0 + 4 * RV_PITCH), van1 = tr_pair(va0 + 64, va0 + 64 + 4 * RV_PITCH);
#pragma unroll
          for (int s = 0; s < 8; ++s) { const bf16x8 pb = pbn, v0 = van0, v1 = van1;
              if (s < 7) { const LAS unsigned char* kb = kb0 + 16 * (s + 1) * RK_PITCH; const LAS unsigned char* va = va0 + 16 * (s + 1) * RV_PITCH;
                  pbn = tr_pair(kb, kb + 4 * RK_PITCH); van0 = tr_pair(va, va + 4 * RV_PITCH); van1 = tr_pair(va + 64, va + 64 + 4 * RV_PITCH); }
              __builtin_amdgcn_sched_barrier(0);
              sacc[0] = MFMA32(v0, pb, sacc[0]); sacc[1] = MFMA32(v1, pb, sacc[1]);
              __builtin_amdgcn_sched_barrier(0); } }
    }
    float* So = F.out + O_RETP + ((size_t)(b * 4 + h) * 256 + 32 * w) * 512 + sl * 64; const unsigned sooff = (unsigned)(r32 * 512 + 4 * hb) * 4u;
#pragma unroll
    for (int e2 = 0; e2 < 2; ++e2)
#pragma unroll
        for (int g = 0; g < 4; ++g) gst<f32x4>(So + 32 * e2 + 8 * g, sooff, (f32x4){sacc[e2][4 * g], sacc[e2][4 * g + 1], sacc[e2][4 * g + 2], sacc[e2][4 * g + 3]});
}
__device__ __forceinline__ void ret_sample_unit(Frame& F, int b, int h) {
#ifdef STUB_RS
    return;
#endif
    const int tid = F.tid, e4 = tid & 127, dg = tid >> 7;
    const float gam = 1.0f - __builtin_amdgcn_exp2f(-5.0f - (float)h);
    const size_t row = (size_t)(MP + b);
    const bf16* Rq = WSP(const bf16, WS_RQ) + row * 1024 + h * 256; const bf16* Rk = WSP(const bf16, WS_RK) + row * 1024 + h * 256;
    const bf16* Rv = WSP(const bf16, WS_RV) + row * 2048 + h * 512; bf16* Ro = WSP(bf16, WS_RO) + row * 2048 + h * 512;
    LAS float* qs = (LAS float*)(F.lds + RING_OFF); LAS float* ks = qs + 256; LAS float* red = ks + 256;
    WG_BAR();
    if (tid < 256) { qs[tid] = bf2f(Rq[tid]); ks[tid] = bf2f(Rk[tid]); }
    const v2u vraw = *(const GAS v2u*)(Rv + 4 * e4); const f32x4 vv = {bflo(vraw.x), bfhi(vraw.x), bflo(vraw.y), bfhi(vraw.y)};
    WG_BAR();
    const float* S0 = INP(I_SRET) + ((size_t)(b * 4 + h) * 256) * 512 + 4 * e4; float* S1 = F.out + O_RETS + ((size_t)(b * 4 + h) * 256) * 512 + 4 * e4;
    f32x4 acc = {0.f, 0.f, 0.f, 0.f};
#pragma unroll 8
    for (int i = 0; i < 64; ++i) { const int d = 4 * i + dg; const f32x4 s = *(const GAS f32x4*)(S0 + (size_t)d * 512);
        acc = acc + s * qs[d]; *(GAS f32x4*)(S1 + (size_t)d * 512) = s * gam + vv * ks[d]; }
    *(LAS f32x4*)(red + dg * 512 + 4 * e4) = acc;
    if (tid < 64) { float s = 0.f;
#pragma unroll
        for (int j = 0; j < 4; ++j) s += qs[tid + 64 * j] * ks[tid + 64 * j];
        s = wave_sum(s); if (tid == 0) red[2048] = s; }
    WG_BAR();
    if (tid < 128) { const f32x4 cr = *(LAS f32x4*)(red + 4 * tid) + *(LAS f32x4*)(red + 512 + 4 * tid) + *(LAS f32x4*)(red + 1024 + 4 * tid) + *(LAS f32x4*)(red + 1536 + 4 * tid);
        const float qk = red[2048]; const f32x4 o = vv * qk + cr * gam;
        v2u w; w.x = pkbf(o.x, o.y); w.y = pkbf(o.z, o.w); *(GAS v2u*)(Ro + 4 * tid) = w; }
}
__device__ __forceinline__ void ret_mix_phase(Frame& F) {
    for (int i = blockIdx.x; i < 256; i += F.G) ret_prompt_unit(F, i >> 5, (i >> 3) & 3, i & 7);
    for (int i = blockIdx.x; i < NB_S * 4; i += F.G) ret_sample_unit(F, i >> 2, i & 3);
}
__device__ __forceinline__ void ret_norm_phase(Frame& F) {
#ifdef STUB_RN
    return;
#endif
    const int gw = blockIdx.x * NWAVES + F.wave, NGW = F.G * NWAVES, lane = F.lane;
    bf16* Ro = WSP(bf16, WS_RO); const bf16* Rg = WSP(const bf16, WS_RG);
    const int per = (MR + NGW - 1) / NGW, r0 = gw * per, r1 = (r0 + per < MR) ? r0 + per : MR;
    v4u xr[4], gr[4], xn[4], gn[4];
    if (r0 < r1) {
#pragma unroll
        for (int hh = 0; hh < 4; ++hh) { const size_t off = (size_t)r0 * 2048 + hh * 512 + 8 * lane; xr[hh] = *(const GAS v4u*)(Ro + off); gr[hh] = *(const GAS v4u*)(Rg + off); } }
    for (int r = r0; r < r1; ++r) {
        if (r + 1 < r1) {
#pragma unroll
            for (int hh = 0; hh < 4; ++hh) { const size_t off = (size_t)(r + 1) * 2048 + hh * 512 + 8 * lane; xn[hh] = *(const GAS v4u*)(Ro + off); gn[hh] = *(const GAS v4u*)(Rg + off); } }
#pragma unroll
        for (int hh = 0; hh < 4; ++hh) {
            const size_t off = (size_t)r * 2048 + hh * 512 + 8 * lane;
            float x[8] = {bflo(xr[hh].x), bfhi(xr[hh].x), bflo(xr[hh].y), bfhi(xr[hh].y), bflo(xr[hh].z), bfhi(xr[hh].z), bflo(xr[hh].w), bfhi(xr[hh].w)};
            const float g[8] = {bflo(gr[hh].x), bfhi(gr[hh].x), bflo(gr[hh].y), bfhi(gr[hh].y), bflo(gr[hh].z), bfhi(gr[hh].z), bflo(gr[hh].w), bfhi(gr[hh].w)};
            float s = 0.f;
#pragma unroll
            for (int e = 0; e < 8; ++e) s += x[e];
            const float mu = wave_sum(s) * (1.0f / 512.0f); float q = 0.f;
#pragma unroll
            for (int e = 0; e < 8; ++e) { x[e] -= mu; q += x[e] * x[e]; }
            const float rs = 1.0f / sqrtf(wave_sum(q) * (1.0f / 512.0f) + 1e-5f);
            v4u o; o.x = pkbf(x[0] * rs * g[0], x[1] * rs * g[1]); o.y = pkbf(x[2] * rs * g[2], x[3] * rs * g[3]); o.z = pkbf(x[4] * rs * g[4], x[5] * rs * g[5]); o.w = pkbf(x[6] * rs * g[6], x[7] * rs * g[7]);
            *(GAS v4u*)(Ro + off) = o;
        }
#pragma unroll
        for (int hh = 0; hh < 4; ++hh) { xr[hh] = xn[hh]; gr[hh] = gn[hh]; }
    }
}

constexpr int MD_PITCH = 272;
constexpr int MD_WB = 0, MD_CB = MD_WB + 128 * MD_PITCH, MD_END = MD_CB + 160 * MD_PITCH;
static_assert(MD_END <= RING_BYTES, "mod LDS map");
__device__ __forceinline__ void mod_direct_tile(Frame& F, int tile) {
    const int tid = F.tid, lane = F.lane, w = F.wave, r32 = lane & 31, hb = lane >> 5, q4 = (lane & 15) >> 2, p4 = lane & 3, blk = (lane >> 4) & 1;
    const int n0 = tile * 128, l = n0 / 9216, cc0 = n0 - l * 9216, sub = cc0 / 3072, jt = (cc0 - sub * 3072) >> 10, d0 = cc0 & 1023;
    const float* W = INP(I_WADA) + (size_t)l * 1024 * 9216 + cc0;
    LAS unsigned char* WB = F.lds + RING_OFF + MD_WB; LAS unsigned char* CB = F.lds + RING_OFF + MD_CB;
    const int nt = w & 3, bg = w >> 2;
    f32x16 acc[3];
#pragma unroll
    for (int j = 0; j < 3; ++j)
#pragma unroll
        for (int i = 0; i < 16; ++i) acc[j][i] = 0.f;
    f32x4 wreg[8], creg[10];
    const float* cpp = INP(I_CP); const float* csp = INP(I_CS);
    const unsigned woff = (unsigned)((tid >> 5) * 9216 + (tid & 31) * 4) * 4u;
#define MD_LOADW(kc) do { _Pragma("unroll") for (int i = 0; i < 8; ++i) wreg[i] = gld<f32x4>(W + (size_t)(128 * (kc) + 16 * i) * 9216, woff); } while (0)
#define MD_LOADC(kc) do { _Pragma("unroll") for (int i = 0; i < 10; ++i) { const int bb = (tid >> 5) + 16 * i, k4 = tid & 31; \
        const float* src = bb < NB_P ? cpp + (size_t)bb * 1024 : csp + (size_t)(bb - NB_P) * 1024; \
        creg[i] = (bb < NB_TOT) ? *(const GAS f32x4*)(src + 128 * (kc) + 4 * k4) : (f32x4){0.f, 0.f, 0.f, 0.f}; } } while (0)
    MD_LOADW(0); MD_LOADC(0);
    for (int kc = 0; kc < 8; ++kc) {
        WG_BAR();
#pragma unroll
        for (int i = 0; i < 8; ++i) { v2u o; o.x = pkbf(wreg[i].x, wreg[i].y); o.y = pkbf(wreg[i].z, wreg[i].w); *(LAS v2u*)(WB + ((tid >> 5) + 16 * i) * MD_PITCH + (tid & 31) * 8) = o; }
#pragma unroll
        for (int i = 0; i < 10; ++i) { f32x4 s;
#pragma unroll
            for (int e = 0; e < 4; ++e) s[e] = creg[i][e] * __builtin_amdgcn_rcpf(1.0f + __builtin_amdgcn_exp2f(-LOG2E * creg[i][e]));
            v2u o; o.x = pkbf(s.x, s.y); o.y = pkbf(s.z, s.w); *(LAS v2u*)(CB + ((tid >> 5) + 16 * i) * MD_PITCH + (tid & 31) * 8) = o; }
        WG_BAR();
        if (kc < 7) { MD_LOADW(kc + 1); MD_LOADC(kc + 1); }
#pragma unroll
        for (int ks = 0; ks < 8; ++ks) {
            const LAS unsigned char* a = WB + (16 * ks + 8 * hb + q4) * MD_PITCH + (32 * nt + 16 * blk) * 2 + 8 * p4;
            const bf16x8 af = tr_pair(a, a + 4 * MD_PITCH);
#pragma unroll
            for (int j = 0; j < 3; ++j) { const int bt = bg + 2 * j;
                if (bt < 5) { const bf16x8 bfr = *(const LAS bf16x8*)(CB + (32 * bt + r32) * MD_PITCH + (16 * ks + 8 * hb) * 2); acc[j] = MFMA32(af, bfr, acc[j]); } }
        }
    }
#undef MD_LOADW2
#undef MD_LOADW
#undef MD_LOADC
    const float resw = (sub == 1) ? 1.0f : 0.5f; float* T = WSP(float, WS_MODT);
#pragma unroll
    for (int g = 0; g < 4; ++g) { const int nn = 32 * nt + 8 * g + 4 * hb, gcol = n0 + nn, d = d0 + nn;
        const f32x4 bias = *(const GAS f32x4*)(INP(I_BADA) + gcol);
        f32x4 gv = (f32x4){0.f, 0.f, 0.f, 0.f};
        if (jt == 1) gv = *(const GAS f32x4*)(INP(I_NPRE) + (l * 3 + sub) * 1024 + d);
        if (jt == 2) gv = *(const GAS f32x4*)(INP(I_NPOST) + (l * 3 + sub) * 1024 + d) * resw;
#pragma unroll
        for (int j = 0; j < 3; ++j) { const int bt = bg + 2 * j, bb = 32 * bt + r32;
            if (bt < 5 && bb < NB_TOT) { f32x4 v = (f32x4){acc[j][4 * g], acc[j][4 * g + 1], acc[j][4 * g + 2], acc[j][4 * g + 3]} + bias;
                if (jt == 1) v = gv * (v + 1.0f);
                if (jt == 2) v = gv * v;
                *(GAS f32x4*)(T + (size_t)bb * 18432 + gcol) = v; } }
    }
}
__device__ __forceinline__ void prologue_phase(Frame& F) {
    const int nmod = (F.G * 9) / 16, c = (int)blockIdx.x;
    if (c < nmod) { for (int t = c; t < 144; t += nmod) mod_direct_tile(F, t);
#ifdef DUP_MOD
        for (int t = c; t < 144; t += nmod) mod_direct_tile(F, t);
#endif
    }
    else { conv_set(F, 0, (c - nmod) * NWAVES + F.wave, (F.G - nmod) * NWAVES);
#ifdef DUP_CONV
        conv_set(F, 0, (c - nmod) * NWAVES + F.wave, (F.G - nmod) * NWAVES);
#endif
    }
}
constexpr int N_PHASES = 24;
__global__ void __launch_bounds__(NWAVES * 64, 2) fwd(Args args) {
    extern __shared__ __attribute__((aligned(16))) unsigned char lds[];
    Frame F;
    F.lds = (LAS unsigned char*)lds;
    F.MISC = (volatile LAS unsigned*)(F.lds + MISC_OFF);
    F.tid = threadIdx.x; F.lane = F.tid & 63; F.wave = __builtin_amdgcn_readfirstlane(F.tid >> 6);
    F.G = gridDim.x;
    F.ws = args.ws; F.out = args.out; F.ctl = (gu32*)(args.ws + WS_CTL);
    for (int u = F.tid; u < (LDS_BYTES - LDSCTL_OFF) / 4; u += NWAVES * 64) ((LAS unsigned*)(F.lds + LDSCTL_OFF))[u] = 0u;
    __syncthreads();
    const int lo = args.ph_lo, hi = args.ph_hi;
    const bool use_bar = (hi - lo) > 1;
    XcdBarrier bar; bar.bar = (unsigned*)(F.ctl + CW_BAR); bar.x = 0; bar.st = nullptr;
    if (use_bar) bar = xcd_barrier_post((unsigned*)(F.ctl + CW_BAR), F.MISC + 8, F.tid);
    int p = 0;
#ifndef PROBE_MASK
#define PROBE_MASK 0u
#endif
    unsigned long long pb0 = 0, pb = 0;
#define PRB_BEGIN if (PROBE_MASK != 0u) { if ((PROBE_MASK >> p) & 1u) pb0 = __builtin_amdgcn_s_memrealtime(); }
#define PRB_END if (PROBE_MASK != 0u) { if ((PROBE_MASK >> p) & 1u) pb += __builtin_amdgcn_s_memrealtime() - pb0; }
#define PH_BEGIN PRB_BEGIN if (p >= lo && p < hi) { asm volatile("" : "+s"(F.ws), "+s"(cu)); asm volatile("" : "+v"(F.tid)); F.lane = F.tid & 63; F.wave = __builtin_amdgcn_readfirstlane(F.tid >> 6);
#define PH_END } if (p >= lo && p + 1 < hi) xcd_barrier(bar, F.tid); PRB_END ++p;
    using namespace pg8;
    PG8_LAS unsigned char* ring = F.lds + RING_OFF;
    int cu = (int)blockIdx.x;

    PH_BEGIN prologue_phase(F); PH_END
    PH_BEGIN seam_phase(F, true, false, true, 0, 0, 1); PH_END

#pragma unroll
    for (int l = 0; l < 2; ++l) {
#pragma unroll
        for (int s = 0; s < 3; ++s) {
            if (s != 1) {
                const int lf = l * 2 + (s >> 1);
                PH_BEGIN { Gemm g{WSP(bf16, WS_H), WSP(bf16, WS_WFIN + lf * WFIN_SZ), MPAD, 5632, 1024}; MixOrder S; S.init(64, 5632, 1024, 1, F.G, cu);
                    EpiSwiGLU E{WSP(bf16, WS_G), DFF};
                    gemm_phase<EpiSwiGLU, MixOrder, true, true>(ring, g, S, E, F.tid); if (lf < 3) conv_in_tail(F, lf + 1, 64 * 22 + 22); } PH_END
                PH_BEGIN { Gemm g{WSP(bf16, WS_G), WSP(bf16, WS_WFOUT + lf * WFOUT_SZ), MPAD, 1024, DFF}; MixOrder S; S.init(64, 1024, DFF, 11, F.G, cu);
                    EpiY E{WSP(bf16, WS_Y), 1024, DFF / 64, WSP(float, WS_YS)};
                    gemm_phase<EpiY, MixOrder, true, true>(ring, g, S, E, F.tid); } PH_END
            } else if (l == 0) {
                PH_BEGIN { Gemm g{WSP(bf16, WS_H), WSP(bf16, WS_WEI), MPAD, 2048, 1024}; MixOrder S; S.init(64, 2048, 1024, 1, F.G, cu);
                    EpiEvenIn E{WSP(bf16, WS_Q), WSP(bf16, WS_KB), WSP(bf16, WS_VB), WSP(float, WS_U), F.out + O_KP, F.out + O_VP, F.out + O_KS, F.out + O_VS, 0.125f * LOG2E, MP, MR};
                    gemm_phase<EpiEvenIn, MixOrder, true, true>(ring, g, S, E, F.tid); } PH_END
                PH_BEGIN even_mix_phase(F); PH_END
                PH_BEGIN { even_post_phase(F);
                    Gemm g{WSP(bf16, WS_D), WSP(bf16, WS_WPOOL), MPAD, 512, 512}; MixOrder S; S.init(64, 512, 512, 1, F.G, cu);
                    EpiPool E{WSP(bf16, WS_O), INP(I_PS)};
                    gemm_phase<EpiPool, MixOrder, true, true>(ring, g, S, E, F.tid); conv_in_tail(F, 4, 64 * 2 + 2); } PH_END
                PH_BEGIN { Gemm g{WSP(bf16, WS_O), WSP(bf16, WS_WEO), MPAD, 1024, 1024}; MixOrder S; S.init(64, 1024, 1024, 4, F.G, cu);
                    EpiY E{WSP(bf16, WS_Y), 1024, 16, WSP(float, WS_YS)};
                    gemm_phase<EpiY, MixOrder, true, true>(ring, g, S, E, F.tid); } PH_END
            } else {
                PH_BEGIN { Gemm g{WSP(bf16, WS_H), WSP(bf16, WS_WOI), MPAD, 6144, 1024}; MixOrder S; S.init(64, 6144, 1024, 1, F.G, cu);
                    EpiOddIn E{WSP(bf16, WS_RQ), WSP(bf16, WS_RK), WSP(bf16, WS_RV), WSP(bf16, WS_RG), MP};
                    gemm_phase<EpiOddIn, MixOrder, true, true>(ring, g, S, E, F.tid); } PH_END
                PH_BEGIN ret_mix_phase(F); PH_END
                PH_BEGIN ret_norm_phase(F); PH_END
                PH_BEGIN { Gemm g{WSP(bf16, WS_RO), WSP(bf16, WS_WOO), MPAD, 1024, 2048}; MixOrder S; S.init(64, 1024, 2048, 8, F.G, cu);
                    EpiY E{WSP(bf16, WS_Y), 1024, 32, WSP(float, WS_YS)};
                    gemm_phase<EpiY, MixOrder, true, true>(ring, g, S, E, F.tid); } PH_END
            }
            PH_BEGIN { const bool last = (l == 1 && s == 2); const int nl = (s == 2) ? l + 1 : l, ns = (s == 2) ? 0 : s + 1;
                seam_phase(F, l == 0 && s == 0, true, !last, l * 9216 + s * 3072, last ? 0 : nl * 9216 + ns * 3072, s != 1 ? 11 : (l == 0 ? 4 : 8)); } PH_END
        }
    }
#undef PH_BEGIN
#undef PH_END
    if (PROBE_MASK != 0u && blockIdx.x == 0 && F.tid == 0) {
        const unsigned long long want = 102400ull * (pb / 800ull), t0 = __builtin_amdgcn_s_memrealtime();
        while (__builtin_amdgcn_s_memrealtime() - t0 < want) __builtin_amdgcn_s_sleep(16);
    }
}

#ifndef MK_PER_PHASE
#define MK_PER_PHASE 0
#endif
extern "C" void kernel_launch(void* const* d_in, const int* in_sizes, int n_in, void* d_out, int out_size, void* d_ws, size_t ws_size, hipStream_t stream) {
    static int grid = 0;
    if (grid == 0) {
        if (n_in != N_IN || (size_t)out_size != O_END || ws_size < WS_END) { fprintf(stderr, "kernel_launch: unexpected shapes (n_in %d out %d ws %zu)\n", n_in, out_size, ws_size); grid = -1; return; }
        int dev = 0, cus = 0, per_cu = 0;
        if (hipGetDevice(&dev) != hipSuccess || hipDeviceGetAttribute(&cus, hipDeviceAttributeMultiprocessorCount, dev) != hipSuccess) { grid = -1; return; }
        if (hipFuncSetAttribute((const void*)fwd, hipFuncAttributeMaxDynamicSharedMemorySize, LDS_BYTES) != hipSuccess) { fprintf(stderr, "kernel_launch: hipFuncSetAttribute failed\n"); grid = -1; return; }
        if (hipOccupancyMaxActiveBlocksPerMultiprocessor(&per_cu, (const void*)fwd, NWAVES * 64, LDS_BYTES) != hipSuccess || per_cu < 1)
            fprintf(stderr, "kernel_launch: note: occupancy query reports %d workgroups per CU\n", per_cu);
        (void)hipGetLastError();
        grid = cus;
    }
    if (grid < 0) return;
    (void)hipMemsetAsync((char*)d_ws + WS_CTL, 0, CTL_ZERO_BYTES, stream);
    Args a{};
    for (int i = 0; i < N_IN; ++i) a.in[i] = (const float*)d_in[i];
    a.out = (float*)d_out; a.ws = (unsigned char*)d_ws;
#if MK_PER_PHASE
    for (int p = 0; p < N_PHASES; ++p) { a.ph_lo = p; a.ph_hi = p + 1; hipLaunchKernelGGL(fwd, dim3(grid), dim3(NWAVES * 64), LDS_BYTES, stream, a); }
#else
    a.ph_lo = 0; a.ph_hi = N_PHASES;
    hipLaunchKernelGGL(fwd, dim3(grid), dim3(NWAVES * 64), LDS_BYTES, stream, a);
#endif
    const hipError_t le = hipPeekAtLastError();
    if (le != hipSuccess) fprintf(stderr, "kernel_launch: launch failed: %s\n", hipGetErrorName(le));
}
```
